# Optimizing an MI355X kernel written in HIP

```python
import math
import jax, jax.numpy as jnp
from jax import lax
import numpy as np

D_MODEL = 1024
BATCH = 8
SEQ = 4096
DEPTH = 2

GRID_W = 64
CTX_LEN = 256
D_FF = 2816
N_MOD = 9
EPS = 1e-6
NEG = -1e30

SSM_WIDTH = 384
SSM_GROUP = 16
SSM_GROUPS = SSM_WIDTH // SSM_GROUP
SSM_STATE = 64
DT_MIN = 1e-3
DT_MAX = 1e-1

HEAD_DIM = 64
GQA_HEADS = 8
GQA_KV_HEADS = 2
GQA_WIDTH = GQA_HEADS * HEAD_DIM
GQA_KV_WIDTH = GQA_KV_HEADS * HEAD_DIM
WINDOW = 128
Q_BLOCK = 128
ROPE_THETA = 10000.0

NA_HEADS = 8
NA_WIDTH = NA_HEADS * HEAD_DIM
NA_ROWS_MAX = 8
NA_COLS = 16

N_BRANCH = 3
IN_SPLITS = (SSM_WIDTH, GQA_WIDTH, GQA_KV_WIDTH, GQA_KV_WIDTH, NA_WIDTH, NA_WIDTH, NA_WIDTH, N_BRANCH * D_MODEL)
N_IN = SSM_WIDTH + GQA_WIDTH + 2 * GQA_KV_WIDTH + 3 * NA_WIDTH + N_BRANCH * D_MODEL

kernel_name = "hybrid_s5_swa_natten_prefix_dit_block"


def rmsnorm(x, g):
    xf = x.astype(jnp.float32)
    y = xf * lax.rsqrt(jnp.mean(xf * xf, axis=-1, keepdims=True) + EPS)
    return (y * g.astype(jnp.float32)).astype(x.dtype)


def modulate(h, shift, scale):
    return h * (1.0 + scale) + shift


def swiglu(h, wg, wu, wd):
    return (jax.nn.silu(h @ wg) * (h @ wu)) @ wd


def split_in(z):
    offs = np.cumsum(IN_SPLITS)[:-1]
    return jnp.split(z, [int(o) for o in offs], axis=-1)


def to_heads(t, n):
    return t.reshape(t.shape[:2] + (n, HEAD_DIM))


def joint_softmax(parts, sink=None):
    sizes = [p.shape[-1] for p in parts]
    cols = list(parts)
    if sink is not None:
        cols.append(jnp.broadcast_to(sink, parts[0].shape[:-1] + (1,)))
    probs = jax.nn.softmax(jnp.concatenate(cols, axis=-1), axis=-1)
    offs = np.cumsum(sizes)
    return [probs[..., int(o) - s:int(o)] for o, s in zip(offs, sizes)]


def axial_rope_tables(n_tokens):
    t = jnp.arange(n_tokens)
    pos = jnp.stack([t // GRID_W, t % GRID_W], axis=-1).astype(jnp.float32)
    half = HEAD_DIM // 2
    inv = ROPE_THETA ** (-jnp.arange(0, half, 2, dtype=jnp.float32) / half)
    ang = pos[:, :, None] * inv
    return jnp.cos(ang), jnp.sin(ang)


def apply_axial_rope(x, cos, sin):
    b_, l_, h_, _ = x.shape
    xs = x.reshape(b_, l_, h_, 2, 2, HEAD_DIM // 4)
    x1, x2 = xs[..., 0, :], xs[..., 1, :]
    cs, sn = cos[None, :, None], sin[None, :, None]
    out = jnp.stack([x1 * cs - x2 * sn, x1 * sn + x2 * cs], axis=-2)
    return out.reshape(x.shape).astype(x.dtype)


def s5_discretize(a_re, a_im, log_dt, b_re, b_im):
    f32 = jnp.float32
    lam = lax.complex(a_re.astype(f32), a_im.astype(f32))
    dt = jnp.exp(log_dt.astype(f32))[:, None]
    lam_bar = jnp.exp(lam * dt)
    b = lax.complex(b_re.astype(f32), b_im.astype(f32))
    b_bar = ((lam_bar - 1.0) / lam)[..., None] * b
    return lam_bar, b_bar


def s5_scan(u, lam_bar, b_bar, s0):
    bu = lax.complex(jnp.einsum('blgi,gpi->blgp', u, b_bar.real),
                     jnp.einsum('blgi,gpi->blgp', u, b_bar.imag))
    if s0 is not None:
        bu = bu.at[:, 0].add(lam_bar * s0)
    a = jnp.broadcast_to(lam_bar, (1, u.shape[1]) + lam_bar.shape)

    def combine(left, right):
        a_l, b_l = left
        a_r, b_r = right
        return a_l * a_r, a_r * b_l + b_r

    _, states = lax.associative_scan(combine, (a, bu), axis=1)
    return states


def s5_readout(states, c_re, c_im):
    return (jnp.einsum('blgp,gip->blgi', states.real, c_re)
            - jnp.einsum('blgp,gip->blgi', states.imag, c_im))


def s5_mixer(u, uc, p, ctx_out):
    f32 = jnp.float32
    b_, l_, _ = u.shape
    n_c = uc.shape[1]
    ul = u.astype(f32).reshape(b_, l_, SSM_GROUPS, SSM_GROUP)
    ucg = uc.astype(f32).reshape(b_, n_c, SSM_GROUPS, SSM_GROUP)
    d = p['ssm_d'].astype(f32).reshape(SSM_GROUPS, SSM_GROUP)
    y = d * ul
    yc = d * ucg if ctx_out else None
    for direction in range(2):
        lam_bar, b_bar = s5_discretize(p['ssm_a_re'][direction], p['ssm_a_im'][direction],
                                       p['ssm_log_dt'][direction], p['ssm_b_re'][direction], p['ssm_b_im'][direction])
        c_re = p['ssm_c_re'][direction].astype(f32)
        c_im = p['ssm_c_im'][direction].astype(f32)
        rev = (lambda t: jnp.flip(t, axis=1)) if direction == 1 else (lambda t: t)
        st_c = s5_scan(rev(ucg), lam_bar, b_bar, None)
        st_l = s5_scan(rev(ul), lam_bar, b_bar, st_c[:, -1])
        y = y + rev(s5_readout(st_l, c_re, c_im))
        if ctx_out:
            yc = yc + rev(s5_readout(st_c, c_re, c_im))
    w_glu = p['ssm_w_glu']

    def glu(t):
        t = jax.nn.gelu(t.reshape(t.shape[:2] + (SSM_WIDTH,)))
        return (t * jax.nn.sigmoid(t @ w_glu)).astype(u.dtype)

    return glu(y), (glu(yc) if ctx_out else None)


def window_gqa_latent(q, k, v, kc, vc, sink):
    b_, l_, h_, dh = q.shape
    grp = h_ // GQA_KV_HEADS
    nb = l_ // Q_BLOCK
    span = Q_BLOCK + 2 * WINDOW
    scale = dh ** -0.5
    pad = ((0, 0), (WINDOW, WINDOW), (0, 0), (0, 0))
    kp, vp = jnp.pad(k, pad), jnp.pad(v, pad)
    qb = q.reshape(b_, nb, Q_BLOCK, GQA_KV_HEADS, grp, dh).transpose(1, 0, 2, 3, 4, 5)
    sink_l = sink.astype(jnp.float32).reshape(GQA_KV_HEADS, grp)[None, :, :, None, None]

    def block(args):
        i, qi = args
        start = i * Q_BLOCK
        kb = lax.dynamic_slice_in_dim(kp, start, span, axis=1)
        vb = lax.dynamic_slice_in_dim(vp, start, span, axis=1)
        qpos = start + jnp.arange(Q_BLOCK)
        kpos = start - WINDOW + jnp.arange(span)
        valid = ((jnp.abs(qpos[:, None] - kpos[None, :]) <= WINDOW)
                 & (kpos >= 0)[None, :] & (kpos < l_)[None, :])
        s_loc = jnp.einsum('bqkgd,bskd->bkgqs', qi, kb, preferred_element_type=jnp.float32) * scale
        s_loc = jnp.where(valid, s_loc, NEG)
        s_ctx = jnp.einsum('bqkgd,bckd->bkgqc', qi, kc, preferred_element_type=jnp.float32) * scale
        p_loc, p_ctx = joint_softmax([s_loc, s_ctx], sink_l)
        return (jnp.einsum('bkgqs,bskd->bqkgd', p_loc.astype(v.dtype), vb)
                + jnp.einsum('bkgqc,bckd->bqkgd', p_ctx.astype(v.dtype), vc))

    out = lax.map(block, (jnp.arange(nb), qb))
    return out.transpose(1, 0, 2, 3, 4, 5).reshape(b_, l_, h_ * dh)


def neighborhood_attn_latent(q, k, v, kc, vc, rpb):
    b_, l_, h_, dh = q.shape
    rows = l_ // GRID_W
    kh = min(NA_ROWS_MAX, rows)
    kw = NA_COLS
    scale = dh ** -0.5
    qg = q.reshape(b_, rows, GRID_W, h_, dh).transpose(1, 0, 2, 3, 4)
    kg = k.reshape(b_, rows, GRID_W, h_, dh)
    vg = v.reshape(b_, rows, GRID_W, h_, dh)
    cols = np.arange(GRID_W)
    col_start = np.clip(cols - kw // 2, 0, GRID_W - kw)
    col_idx = col_start[:, None] + np.arange(kw)[None, :]
    col_bias_idx = col_idx - cols[:, None] + (kw - 1)
    rpb_c = rpb.astype(jnp.float32)[:, :, col_bias_idx]

    def row_block(args):
        r, qr = args
        rs = jnp.clip(r - kh // 2, 0, rows - kh)
        kband = lax.dynamic_slice_in_dim(kg, rs, kh, axis=1)
        vband = lax.dynamic_slice_in_dim(vg, rs, kh, axis=1)
        k_nb = kband[:, :, col_idx]
        v_nb = vband[:, :, col_idx]
        row_bias_idx = rs + jnp.arange(kh) - r + (NA_ROWS_MAX - 1)
        bias = rpb_c[:, row_bias_idx].transpose(0, 2, 1, 3)
        s_loc = jnp.einsum('bchd,bicjhd->bhcij', qr, k_nb, preferred_element_type=jnp.float32) * scale + bias[None]
        s_loc = s_loc.reshape(b_, h_, GRID_W, kh * kw)
        s_ctx = jnp.einsum('bchd,bkhd->bhck', qr, kc, preferred_element_type=jnp.float32) * scale
        p_loc, p_ctx = joint_softmax([s_loc, s_ctx])
        p_loc = p_loc.reshape(b_, h_, GRID_W, kh, kw)
        return (jnp.einsum('bhcij,bicjhd->bchd', p_loc.astype(v.dtype), v_nb)
                + jnp.einsum('bhck,bkhd->bchd', p_ctx.astype(v.dtype), vc))

    out = lax.map(row_block, (jnp.arange(rows), qg))
    return out.transpose(1, 0, 2, 3, 4).reshape(b_, l_, h_ * dh)


def context_self_attn(q, k, v, sink):
    b_, n_c, h_, dh = q.shape
    hkv = k.shape[2]
    grp = h_ // hkv
    qg = q.reshape(b_, n_c, hkv, grp, dh)
    s = jnp.einsum('bqkgd,bckd->bkgqc', qg, k, preferred_element_type=jnp.float32) * dh ** -0.5
    sk = None if sink is None else sink.astype(jnp.float32).reshape(hkv, grp)[None, :, :, None, None]
    (pr,) = joint_softmax([s], sk)
    o = jnp.einsum('bkgqc,bckd->bqkgd', pr.astype(v.dtype), v)
    return o.reshape(b_, n_c, h_ * dh)


def merge_branches(y_ssm, y_gqa, y_na, gates, p):
    g_s, g_a, g_n = jnp.split(gates, N_BRANCH, axis=-1)
    m = (jax.nn.sigmoid(g_s) * (y_ssm @ p['w_p_ssm'])
         + jax.nn.sigmoid(g_a) * (y_gqa @ p['w_p_gqa'])
         + jax.nn.sigmoid(g_n) * (y_na @ p['w_p_na']))
    return m @ p['w_out']


def ffn_half(h_stream, m, gain, w):
    h = modulate(rmsnorm(h_stream, gain), m[0], m[1])
    return h_stream + 0.5 * m[2] * swiglu(h, *w)


def trunk_layer(x, xc, p, cos, sin, ctx_out):
    ml = jnp.split(p['mod_lat'], N_MOD, axis=-1)
    mc = jnp.split(p['mod_ctx'], N_MOD, axis=-1)
    g = p['norm_g']
    x = ffn_half(x, ml[0:3], g[0], p['ffn1'])
    xc = ffn_half(xc, mc[0:3], g[0], p['ffn1'])
    h = modulate(rmsnorm(x, g[1]), ml[3], ml[4])
    hc = modulate(rmsnorm(xc, g[1]), mc[3], mc[4])
    u, gq, gk, gv, nq, nk, nv, gates = split_in(h @ p['w_in'])
    uc, gqc, gkc, gvc, nqc, nkc, nvc, gates_c = split_in(hc @ p['w_in'])
    y_ssm, y_ssm_c = s5_mixer(u, uc, p, ctx_out)
    kc_a, vc_a = to_heads(gkc, GQA_KV_HEADS), to_heads(gvc, GQA_KV_HEADS)
    y_gqa = window_gqa_latent(apply_axial_rope(to_heads(gq, GQA_HEADS), cos, sin),
                              apply_axial_rope(to_heads(gk, GQA_KV_HEADS), cos, sin),
                              to_heads(gv, GQA_KV_HEADS), kc_a, vc_a, p['gqa_sink'])
    kc_n, vc_n = to_heads(nkc, NA_HEADS), to_heads(nvc, NA_HEADS)
    y_na = neighborhood_attn_latent(to_heads(nq, NA_HEADS), to_heads(nk, NA_HEADS), to_heads(nv, NA_HEADS),
                                    kc_n, vc_n, p['na_rpb'])
    x = x + ml[5] * merge_branches(y_ssm, y_gqa, y_na, gates, p)
    if ctx_out:
        y_gqa_c = context_self_attn(to_heads(gqc, GQA_HEADS), kc_a, vc_a, p['gqa_sink'])
        y_na_c = context_self_attn(to_heads(nqc, NA_HEADS), kc_n, vc_n, None)
        xc = xc + mc[5] * merge_branches(y_ssm_c, y_gqa_c, y_na_c, gates_c, p)
    x = ffn_half(x, ml[6:9], g[2], p['ffn2'])
    if ctx_out:
        xc = ffn_half(xc, mc[6:9], g[2], p['ffn2'])
    return x, xc


def setup_inputs(seed: int = 0) -> dict:
    key = jax.random.key(seed)
    ks = iter(jax.random.split(key, 40))
    f32 = jnp.float32

    def nrm(shape, s):
        return jax.random.normal(next(ks), shape, f32) * s

    D, F, G, P, I = D_MODEL, D_FF, SSM_GROUPS, SSM_STATE, SSM_GROUP
    return {
        'x': nrm((BATCH, SEQ, D), 1.0),
        'c': nrm((BATCH, D), 1.0),
        'ctx': nrm((BATCH, CTX_LEN, D), 1.0),
        'c_ctx': nrm((D,), 1.0),
        'w_ada': nrm((DEPTH, D, N_MOD * D), 0.5 * D ** -0.5),
        'b_ada': nrm((DEPTH, N_MOD * D), 0.02),
        'norm_g': 1.0 + nrm((DEPTH, 3, D), 0.02),
        'ffn1_wg': nrm((DEPTH, D, F), D ** -0.5),
        'ffn1_wu': nrm((DEPTH, D, F), D ** -0.5),
        'ffn1_wd': nrm((DEPTH, F, D), F ** -0.5),
        'ffn2_wg': nrm((DEPTH, D, F), D ** -0.5),
        'ffn2_wu': nrm((DEPTH, D, F), D ** -0.5),
        'ffn2_wd': nrm((DEPTH, F, D), F ** -0.5),
        'w_in': nrm((DEPTH, D, N_IN), D ** -0.5),
        'ssm_a_re': -0.5 + nrm((DEPTH, 2, G, P), 0.01),
        'ssm_a_im': math.pi * jnp.arange(P, dtype=f32) + nrm((DEPTH, 2, G, P), 0.01),
        'ssm_log_dt': jax.random.uniform(next(ks), (DEPTH, 2, G), f32, math.log(DT_MIN), math.log(DT_MAX)),
        'ssm_b_re': nrm((DEPTH, 2, G, P, I), (2 * I) ** -0.5),
        'ssm_b_im': nrm((DEPTH, 2, G, P, I), (2 * I) ** -0.5),
        'ssm_c_re': nrm((DEPTH, 2, G, I, P), P ** -0.5),
        'ssm_c_im': nrm((DEPTH, 2, G, I, P), P ** -0.5),
        'ssm_d': nrm((DEPTH, SSM_WIDTH), 1.0),
        'ssm_w_glu': nrm((DEPTH, SSM_WIDTH, SSM_WIDTH), SSM_WIDTH ** -0.5),
        'gqa_sink': nrm((DEPTH, GQA_HEADS), 0.5),
        'na_rpb': nrm((DEPTH, NA_HEADS, 2 * NA_ROWS_MAX - 1, 2 * NA_COLS - 1), 0.1),
        'w_p_ssm': nrm((DEPTH, SSM_WIDTH, D), SSM_WIDTH ** -0.5),
        'w_p_gqa': nrm((DEPTH, GQA_WIDTH, D), GQA_WIDTH ** -0.5),
        'w_p_na': nrm((DEPTH, NA_WIDTH, D), NA_WIDTH ** -0.5),
        'w_out': nrm((DEPTH, D, D), D ** -0.5),
        'final_g': 1.0 + nrm((D,), 0.02),
    }


def reference(x, c, ctx, c_ctx, w_ada, b_ada, norm_g, ffn1_wg, ffn1_wu, ffn1_wd, ffn2_wg, ffn2_wu, ffn2_wd,
              w_in, ssm_a_re, ssm_a_im, ssm_log_dt, ssm_b_re, ssm_b_im, ssm_c_re, ssm_c_im, ssm_d, ssm_w_glu,
              gqa_sink, na_rpb, w_p_ssm, w_p_gqa, w_p_na, w_out, final_g):
    cos, sin = axial_rope_tables(x.shape[1])
    xc = ctx
    s_lat = jax.nn.silu(c)
    s_ctx = jax.nn.silu(c_ctx)
    for l in range(DEPTH):
        p = {
            'mod_lat': (s_lat @ w_ada[l] + b_ada[l])[:, None, :],
            'mod_ctx': (s_ctx @ w_ada[l] + b_ada[l])[None, None, :],
            'norm_g': norm_g[l],
            'ffn1': (ffn1_wg[l], ffn1_wu[l], ffn1_wd[l]),
            'ffn2': (ffn2_wg[l], ffn2_wu[l], ffn2_wd[l]),
            'w_in': w_in[l],
            'ssm_a_re': ssm_a_re[l], 'ssm_a_im': ssm_a_im[l], 'ssm_log_dt': ssm_log_dt[l],
            'ssm_b_re': ssm_b_re[l], 'ssm_b_im': ssm_b_im[l],
            'ssm_c_re': ssm_c_re[l], 'ssm_c_im': ssm_c_im[l],
            'ssm_d': ssm_d[l], 'ssm_w_glu': ssm_w_glu[l],
            'gqa_sink': gqa_sink[l], 'na_rpb': na_rpb[l],
            'w_p_ssm': w_p_ssm[l], 'w_p_gqa': w_p_gqa[l], 'w_p_na': w_p_na[l], 'w_out': w_out[l],
        }
        x, xc = trunk_layer(x, xc, p, cos, sin, l < DEPTH - 1)
    return rmsnorm(x, final_g)
```

```cpp
#include <hip/hip_runtime.h>
#include <hip/hip_cooperative_groups.h>
#include <cstdio>
#include <cstdint>
namespace cg = cooperative_groups;
namespace pg8 {
#define PG8_LAS __attribute__((address_space(3)))
typedef unsigned short bf16_t;
typedef short bf16x8 __attribute__((ext_vector_type(8)));
typedef float f32x4 __attribute__((ext_vector_type(4)));
typedef unsigned u32x4 __attribute__((ext_vector_type(4)));
constexpr int BM = 256, BK = 64, HALF = 128, HTB = HALF * BK * 2  , STAGE_BYTES = 8 * HTB, NXCD = 8, WGM = 4;

__host__ __device__ __forceinline__ int lds_byte(int r, int c) { const int st = (r >> 4) * 2 + (c >> 5), rr = r & 15, cc = c & 31, ob = rr * 64 + cc * 2; return st * 1024 + (ob ^ (((ob >> 9) & 1) << 5)); }
__host__ __device__ __forceinline__ void stage_rc(int b, int& R, int& C) { const int st = b / 1024, sb = b % 1024, swz = sb ^ (((sb >> 9) & 1) << 5); R = (st >> 1) * 16 + swz / 64; C = (st & 1) * 32 + (swz % 64) / 2; }
__host__ __device__ __forceinline__ int perm32(int rho) { const int n = rho >> 4, i = rho & 15; return 8 * (i >> 2) + 4 * n + (i & 3); }

struct Unit { int pm, pn; };
struct Gemm { const bf16_t* A; const bf16_t* Bt; int M, N, K, lda, ldb; };

struct StaticOrder {
    int nM, nN, nwg, G, c;
    __host__ __device__ void init(int M, int N, int G_, int c_) { nM = M / BM; nN = N / BM; nwg = nM * nN; G = G_; c = c_; }
    __host__ __device__ bool next(int i, Unit& u) const {
        const long L = (long)i * G + c; if (L >= nwg) return false;
        int wgid = (int)L; { const int q = nwg / NXCD, r = nwg % NXCD, xcd = wgid % NXCD, off = wgid / NXCD; wgid = (xcd < r ? xcd * (q + 1) : r * (q + 1) + (xcd - r) * q) + off; }
        const int nig = WGM * nN, gid = wgid / nig, fm = gid * WGM, gsz = (nM - fm) < WGM ? (nM - fm) : WGM;
        u.pm = fm + ((wgid % nig) % gsz); u.pn = (wgid % nig) / gsz; return true;
    }
    __device__ __forceinline__ void a_ready(const Unit&) const {}
    __device__ __forceinline__ void done(const Unit&) const {}
};

struct G3L1Order {
    StaticOrder S1; int G, c;
    __host__ __device__ void init(int Mlat, int N, int G_, int c_) { S1.init(Mlat, N, G_, c_); G = G_; c = c_; }
    __host__ __device__ bool next(int i, Unit& u) const {
        if (S1.next(i, u)) return true;
        const long L = (long)i * G + c - S1.nwg; if (L < 0 || L >= 72) return false;
        const int t = (int)L, pt = t % 9; u.pm = 128 + t / 9; u.pn = pt < 2 ? pt : (pt < 4 ? pt + 1 : pt + 2); return true;
    }
    __device__ __forceinline__ void a_ready(const Unit&) const {}
    __device__ __forceinline__ void done(const Unit&) const {}
};
__device__ __forceinline__ unsigned cvt_pk_bf16(float lo, float hi) { unsigned r; asm volatile("v_cvt_pk_bf16_f32 %0, %1, %2" : "=v"(r) : "v"(lo), "v"(hi)); return r; }
template <class Epi, class Sched, bool ALIGN_EPI = false, bool SP2 = false>
__device__ __forceinline__ void gemm_phase(PG8_LAS unsigned char* lds, const Gemm g, const Sched& S, const Epi& E) {
    int tid = threadIdx.x; asm volatile("" : "+v"(tid));
    const int wid = __builtin_amdgcn_readfirstlane(tid >> 6), lane = tid & 63, wr = wid >> 2, wc = wid & 3, fr = lane & 15, fq = lane >> 4;
    const int K = g.K, nt = K / BK;
    unsigned voffA[2], voffB[2];
#pragma unroll
    for (int i = 0; i < 2; ++i) { int R, C; stage_rc(tid * 16 + i * 8192, R, C); const int Rb = Epi::PERM ? ((R & ~31) + perm32(R & 31)) : R;
        voffA[i] = (unsigned)(R * g.lda + C) * 2u; voffB[i] = (unsigned)(Rb * g.ldb + C) * 2u; }
    const size_t kstep = (size_t)(BK * 2);
    const size_t hstepA = (size_t)HALF * g.lda * 2, hstepB = (size_t)HALF * g.ldb * 2;
    const size_t tstepA = 2 * hstepA, tstepB = 2 * hstepB;
    const unsigned ldsw = (unsigned)wid * 1024u;
    const int aoff = lds_byte(wr * 64 + fr, fq * 8), boff = lds_byte(wc * 32 + fr, fq * 8);
#define PG8_SA(b, h) (((b) * 2 + (h)) * HTB)
#define PG8_SB(b, h) ((4 + (b) * 2 + (h)) * HTB)
#define PG8_STAGE(bufoff, gbase, voff) do { _Pragma("unroll") for (int _i = 0; _i < 2; ++_i) \
        __builtin_amdgcn_global_load_lds((const unsigned*)((const char*)(gbase) + (voff)[_i]), (PG8_LAS unsigned*)(lds + (bufoff) + ldsw + _i * 8192), 16, 0, 0); } while (0)
#define PG8_LDA(dst, b, h) do { _Pragma("unroll") for (int m = 0; m < 4; ++m) _Pragma("unroll") for (int k = 0; k < 2; ++k) dst[m][k] = *(const PG8_LAS bf16x8*)(lds + PG8_SA(b, h) + aoff + m * 2048 + k * 1024); } while (0)
#define PG8_LDB(dst, b, h) do { _Pragma("unroll") for (int n = 0; n < 2; ++n) _Pragma("unroll") for (int k = 0; k < 2; ++k) dst[n][k] = *(const PG8_LAS bf16x8*)(lds + PG8_SB(b, h) + boff + n * 2048 + k * 1024); } while (0)
#define PG8_MMA(ai, bj, At, Bt) do { __builtin_amdgcn_s_setprio(1); _Pragma("unroll") for (int m = 0; m < 4; ++m) _Pragma("unroll") for (int n = 0; n < 2; ++n) _Pragma("unroll") for (int k = 0; k < 2; ++k) \
        acc[ai][bj][m][n] = __builtin_amdgcn_mfma_f32_16x16x32_bf16(Bt[n][k], At[m][k], acc[ai][bj][m][n], 0, 0, 0); __builtin_amdgcn_s_setprio(0); } while (0)
#define PG8_WAIT_V(n) asm volatile("s_waitcnt vmcnt(" #n ")" ::: "memory")
#define PG8_WAIT_L(n) asm volatile("s_waitcnt lgkmcnt(" #n ")" ::: "memory")
#define PG8_BAR __builtin_amdgcn_s_barrier()
#define PG8_SCHED __builtin_amdgcn_sched_barrier(0)
    Unit cur, nxt; int ui = 0;
    if (!S.next(0, cur)) return;
    f32x4 acc[2][2][4][2];
#pragma unroll
    for (int a = 0; a < 2; ++a)
#pragma unroll
        for (int b = 0; b < 2; ++b)
#pragma unroll
            for (int m = 0; m < 4; ++m)
#pragma unroll
                for (int n = 0; n < 2; ++n) acc[a][b][m][n] = (f32x4){0.f, 0.f, 0.f, 0.f};
    bf16x8 At[4][2], B0[2][2], B1[2][2];
    const char* cA = (const char*)g.A + (size_t)cur.pm * tstepA; const char* cB = (const char*)g.Bt + (size_t)cur.pn * tstepB;
    S.a_ready(cur);
    if constexpr (SP2) {
        PG8_STAGE(PG8_SB(0, 0), cB, voffB); PG8_STAGE(PG8_SB(0, 1), cB + hstepB, voffB); PG8_STAGE(PG8_SA(0, 0), cA, voffA); PG8_STAGE(PG8_SA(0, 1), cA + hstepA, voffA);
        if (wr == 1) PG8_BAR;
        PG8_WAIT_V(2); PG8_BAR;
        PG8_STAGE(PG8_SB(1, 0), cB + kstep, voffB); PG8_STAGE(PG8_SA(1, 0), cA + kstep, voffA); PG8_STAGE(PG8_SB(1, 1), cB + hstepB + kstep, voffB);
        PG8_WAIT_V(6); PG8_BAR;
    } else {
        PG8_STAGE(PG8_SB(0, 0), cB, voffB); PG8_STAGE(PG8_SA(0, 0), cA, voffA); PG8_STAGE(PG8_SB(0, 1), cB + hstepB, voffB); PG8_STAGE(PG8_SA(0, 1), cA + hstepA, voffA);
        if (wr == 1) PG8_BAR;
        PG8_WAIT_V(4); PG8_BAR;
        PG8_STAGE(PG8_SB(1, 0), cB + kstep, voffB); PG8_STAGE(PG8_SA(1, 0), cA + kstep, voffA); PG8_STAGE(PG8_SB(1, 1), cB + hstepB + kstep, voffB);
        PG8_WAIT_V(6); PG8_BAR;
    }
    for (;;) {
        const bool has_next = S.next(ui + 1, nxt);
        const char* nA = has_next ? (const char*)g.A + (size_t)nxt.pm * tstepA : cA; const char* nB = has_next ? (const char*)g.Bt + (size_t)nxt.pn * tstepB : cB;
        for (int t = 0; t < nt; t += 2) {
            const bool last = (t == nt - 2);
            const char* a1 = cA + (size_t)(t + 1) * kstep;
            const char* a2 = last ? nA : cA + (size_t)(t + 2) * kstep; const char* b2 = last ? nB : cB + (size_t)(t + 2) * kstep;
            const char* a3 = a2 + kstep; const char* b3 = b2 + kstep;
            if (last && has_next) S.a_ready(nxt);
            if constexpr (SP2) {
            PG8_LDB(B0, 0, 0); PG8_LDB(B1, 0, 1); PG8_SCHED; PG8_LDA(At, 0, 0); PG8_STAGE(PG8_SA(1, 1), a1 + hstepA, voffA);
            PG8_WAIT_V(8); PG8_WAIT_L(0); PG8_BAR; PG8_MMA(0, 0, At, B0); PG8_MMA(0, 1, At, B1); PG8_BAR; PG8_SCHED;
            PG8_LDA(At, 0, 1); PG8_STAGE(PG8_SB(0, 0), b2, voffB); PG8_STAGE(PG8_SB(0, 1), b2 + hstepB, voffB); PG8_STAGE(PG8_SA(0, 0), a2, voffA);
            PG8_WAIT_V(8); PG8_WAIT_L(0); PG8_BAR; PG8_MMA(1, 0, At, B0); PG8_MMA(1, 1, At, B1); PG8_BAR; PG8_SCHED;
            PG8_LDB(B0, 1, 0); PG8_LDB(B1, 1, 1); PG8_SCHED; PG8_LDA(At, 1, 0); PG8_STAGE(PG8_SA(0, 1), a2 + hstepA, voffA);
            PG8_WAIT_V(8); PG8_WAIT_L(0); PG8_BAR; PG8_MMA(0, 0, At, B0); PG8_MMA(0, 1, At, B1); PG8_BAR; PG8_SCHED;
            PG8_LDA(At, 1, 1); PG8_STAGE(PG8_SB(1, 0), b3, voffB); PG8_STAGE(PG8_SB(1, 1), b3 + hstepB, voffB); PG8_STAGE(PG8_SA(1, 0), a3, voffA);
            PG8_WAIT_V(8); PG8_WAIT_L(0); PG8_BAR; PG8_MMA(1, 0, At, B0); PG8_MMA(1, 1, At, B1); PG8_BAR; PG8_SCHED;
            } else {
            PG8_LDB(B0, 0, 0); PG8_SCHED; PG8_LDA(At, 0, 0); PG8_STAGE(PG8_SA(1, 1), a1 + hstepA, voffA);
            PG8_WAIT_L(8); PG8_BAR; PG8_WAIT_L(0); PG8_MMA(0, 0, At, B0); PG8_BAR; PG8_SCHED;
            PG8_LDB(B1, 0, 1); PG8_STAGE(PG8_SB(0, 0), b2, voffB);
            PG8_BAR; PG8_WAIT_L(0); PG8_MMA(0, 1, At, B1); PG8_BAR;
            PG8_LDA(At, 0, 1); PG8_STAGE(PG8_SA(0, 0), a2, voffA);
            PG8_BAR; PG8_WAIT_L(0); PG8_MMA(1, 0, At, B0); PG8_BAR; PG8_SCHED;
            PG8_STAGE(PG8_SB(0, 1), b2 + hstepB, voffB);
            PG8_WAIT_V(6); PG8_BAR; PG8_MMA(1, 1, At, B1); PG8_BAR;
            PG8_LDB(B0, 1, 0); PG8_SCHED; PG8_LDA(At, 1, 0); PG8_STAGE(PG8_SA(0, 1), a2 + hstepA, voffA);
            PG8_WAIT_L(8); PG8_BAR; PG8_WAIT_L(0); PG8_MMA(0, 0, At, B0); PG8_BAR; PG8_SCHED;
            PG8_LDB(B1, 1, 1); PG8_STAGE(PG8_SB(1, 0), b3, voffB);
            PG8_BAR; PG8_WAIT_L(0); PG8_MMA(0, 1, At, B1); PG8_BAR;
            PG8_LDA(At, 1, 1); PG8_STAGE(PG8_SA(1, 0), a3, voffA);
            PG8_BAR; PG8_WAIT_L(0); PG8_MMA(1, 0, At, B0); PG8_BAR; PG8_SCHED;
            PG8_STAGE(PG8_SB(1, 1), b3 + hstepB, voffB);
            PG8_WAIT_V(6); PG8_BAR; PG8_MMA(1, 1, At, B1); PG8_BAR;
            }
        }
        if constexpr (ALIGN_EPI) { if (wr == 0) PG8_BAR; }
        if constexpr (!Epi::AFTER_DRAIN) { E(acc, cur, wr, wc, fr, fq); S.done(cur); }
        if (!has_next) break;
#pragma unroll
        for (int a = 0; a < 2; ++a)
#pragma unroll
            for (int b = 0; b < 2; ++b)
#pragma unroll
                for (int m = 0; m < 4; ++m)
#pragma unroll
                    for (int n = 0; n < 2; ++n) acc[a][b][m][n] = (f32x4){0.f, 0.f, 0.f, 0.f};
        cur = nxt; cA = nA; cB = nB; ++ui;
        if constexpr (ALIGN_EPI) { if (wr == 1) PG8_BAR; }
    }
    PG8_WAIT_V(0);
    if constexpr (!ALIGN_EPI) { if (wr == 0) PG8_BAR; }
    PG8_BAR;
    if constexpr (Epi::AFTER_DRAIN) { E.fused(acc, cur, wr, wc, fr, fq, lds, wid, lane); S.done(cur); }
#undef PG8_SA
#undef PG8_SB
#undef PG8_STAGE
#undef PG8_LDA
#undef PG8_LDB
#undef PG8_MMA
#undef PG8_WAIT_V
#undef PG8_WAIT_L
#undef PG8_BAR
#undef PG8_SCHED
}
}

#ifndef EXP_G1
#define EXP_G1 0
#endif
#ifndef EXP_SSMA
#define EXP_SSMA 0
#endif
#ifndef EXP_ATTN
#define EXP_ATTN 0
#endif
#ifndef EXP_NORM
#define EXP_NORM 0
#endif
#ifndef EXP_SYNC
#define EXP_SYNC 0
#endif
using pg8::bf16_t; using pg8::bf16x8; using pg8::f32x4; using pg8::u32x4;
#define LAS __attribute__((address_space(3)))
typedef unsigned u32x2 __attribute__((ext_vector_type(2)));
typedef float f32x2 __attribute__((ext_vector_type(2)));
constexpr int DM = 1024, NBATCH = 8, SEQ = 4096, CTXL = 256, DFF = 2816, NIN = 5760, LDZ = 5888;
constexpr int MLAT = NBATCH * SEQ, MCTX = NBATCH * CTXL, MALL = MLAT + MCTX;
constexpr int ZU = 0, ZGQ = 384, ZGK = 896, ZGV = 1024, ZNQ = 1152, ZNK = 1664, ZNV = 2176, ZGATE = 2688, ZM = 1664;
constexpr int NGRP = 24, NCH = 68;
constexpr float LOG2E = 1.4426950408889634f;
constexpr int LDS_BYTES = 147456;
constexpr size_t MiB = 1u << 20;
constexpr size_t WS_MOD = 0, WS_ROPE = 1 * MiB, WS_LAM = WS_ROPE + 65536, WS_LAMT = WS_LAM + 65536, WS_BB = 2 * MiB, WS_CT = 3 * MiB;
constexpr size_t WS_CB = 4 * MiB, WS_XC = 18 * MiB, WS_SLA = 26 * MiB, WS_SLB = 38 * MiB, WS_SLC = 44 * MiB, WS_H = 50 * MiB, WS_Z = 118 * MiB, WS_END = 509 * MiB;
static_assert(WS_Z + (size_t)MALL * LDZ * 2 <= WS_END, "ws map");
constexpr size_t SC_GLU = 0, SC_PSSM = 512 * 384, SC_PGQA = SC_PSSM + 1024 * 384, SC_PNA = SC_PGQA + 1024 * 512, SC_OUT = SC_PNA + 1024 * 512;

__device__ __forceinline__ unsigned f2bf(float f) { unsigned u = __builtin_bit_cast(unsigned, f); return (u + 0x7fffu + ((u >> 16) & 1u)) >> 16; }
__device__ __forceinline__ unsigned pk2(float lo, float hi) { unsigned r; asm("v_cvt_pk_bf16_f32 %0, %1, %2" : "=v"(r) : "v"(lo), "v"(hi)); return r; }
__device__ __forceinline__ float bflo(unsigned w) { return __builtin_bit_cast(float, w << 16); }
__device__ __forceinline__ float bfhi(unsigned w) { return __builtin_bit_cast(float, w & 0xffff0000u); }
__device__ __forceinline__ float sigmoidf_(float x) { return __builtin_amdgcn_rcpf(1.f + __expf(-x)); }
__device__ __forceinline__ float siluf_(float x) { return x * sigmoidf_(x); }
__device__ __forceinline__ float gelu_tanh(float x) { return x * sigmoidf_(1.5957691216057308f * (x + 0.044715f * x * x * x)); }

struct EpiSwiglu {
    static constexpr bool PERM = true, AFTER_DRAIN = false;
    bf16_t* O; int ldo;
    __device__ __forceinline__ void operator()(const f32x4 (&acc)[2][2][4][2], const pg8::Unit& u, int wr, int wc, int fr, int fq) const {
        const int row0 = u.pm * 256 + wr * 64 + fr, col0 = u.pn * 128 + wc * 32 + 8 * fq;
#pragma unroll
        for (int ai = 0; ai < 2; ++ai)
#pragma unroll
            for (int m = 0; m < 4; ++m) {
                bf16_t* rowp = O + (size_t)(row0 + ai * 128 + m * 16) * ldo + col0;
                const f32x4 g0 = acc[ai][0][m][0], g1 = acc[ai][0][m][1], u0 = acc[ai][1][m][0], u1 = acc[ai][1][m][1];
                u32x4 w;
                w.x = pk2(siluf_(g0[0]) * u0[0], siluf_(g0[1]) * u0[1]); w.y = pk2(siluf_(g0[2]) * u0[2], siluf_(g0[3]) * u0[3]);
                w.z = pk2(siluf_(g1[0]) * u1[0], siluf_(g1[1]) * u1[1]); w.w = pk2(siluf_(g1[2]) * u1[2], siluf_(g1[3]) * u1[3]);
                *(u32x4*)rowp = w;
            }
    }
};
struct EpiStore {
    static constexpr bool PERM = true, AFTER_DRAIN = false;
    bf16_t* O; int ldo;
    __device__ __forceinline__ void operator()(const f32x4 (&acc)[2][2][4][2], const pg8::Unit& u, int wr, int wc, int fr, int fq) const {
        const int row0 = u.pm * 256 + wr * 64 + fr, col0 = u.pn * 256 + wc * 32 + 8 * fq;
#pragma unroll
        for (int ai = 0; ai < 2; ++ai)
#pragma unroll
            for (int m = 0; m < 4; ++m)
#pragma unroll
                for (int bj = 0; bj < 2; ++bj) {
                    const f32x4 v0 = acc[ai][bj][m][0], v1 = acc[ai][bj][m][1];
                    u32x4 w; w.x = pk2(v0[0], v0[1]); w.y = pk2(v0[2], v0[3]); w.z = pk2(v1[0], v1[1]); w.w = pk2(v1[2], v1[3]);
                    *(u32x4*)(O + (size_t)(row0 + ai * 128 + m * 16) * ldo + col0 + bj * 128) = w;
                }
    }
};
struct EpiGlu {
    static constexpr bool PERM = true, AFTER_DRAIN = false;
    const bf16_t* T; bf16_t* YS;
    __device__ __forceinline__ void operator()(const f32x4 (&acc)[2][2][4][2], const pg8::Unit& u, int wr, int wc, int fr, int fq) const {
        const int row0 = u.pm * 256 + wr * 64 + fr, col0 = u.pn * 256 + wc * 32 + 8 * fq;
#pragma unroll
        for (int ai = 0; ai < 2; ++ai)
#pragma unroll
            for (int m = 0; m < 4; ++m)
#pragma unroll
                for (int bj = 0; bj < 2; ++bj) {
                    const size_t row = (size_t)(row0 + ai * 128 + m * 16); const int col = col0 + bj * 128;
                    const u32x4 t = *(const u32x4*)(T + row * LDZ + col);
                    const f32x4 v0 = acc[ai][bj][m][0], v1 = acc[ai][bj][m][1];
                    u32x4 w;
                    w.x = pk2(bflo(t.x) * sigmoidf_(v0[0]), bfhi(t.x) * sigmoidf_(v0[1])); w.y = pk2(bflo(t.y) * sigmoidf_(v0[2]), bfhi(t.y) * sigmoidf_(v0[3]));
                    w.z = pk2(bflo(t.z) * sigmoidf_(v1[0]), bfhi(t.z) * sigmoidf_(v1[1])); w.w = pk2(bflo(t.w) * sigmoidf_(v1[2]), bfhi(t.w) * sigmoidf_(v1[3]));
                    *(u32x4*)(YS + row * 512 + col) = w;
                    asm volatile("" ::: "memory");
                }
    }
};
struct EpiMerge {
    static constexpr bool PERM = true, AFTER_DRAIN = false;
    const bf16_t* Gt; bf16_t* Mo; int first;
    __device__ __forceinline__ void operator()(const f32x4 (&acc)[2][2][4][2], const pg8::Unit& u, int wr, int wc, int fr, int fq) const {
        const int row0 = u.pm * 256 + wr * 64 + fr, col0 = u.pn * 256 + wc * 32 + 8 * fq;
#pragma unroll
        for (int ai = 0; ai < 2; ++ai)
#pragma unroll
            for (int m = 0; m < 4; ++m)
#pragma unroll
                for (int bj = 0; bj < 2; ++bj) {
                    const size_t off = (size_t)(row0 + ai * 128 + m * 16) * LDZ + col0 + bj * 128;
                    const u32x4 gt = *(const u32x4*)(Gt + off);
                    const f32x4 v0 = acc[ai][bj][m][0], v1 = acc[ai][bj][m][1];
                    float o[8] = {sigmoidf_(bflo(gt.x)) * v0[0], sigmoidf_(bfhi(gt.x)) * v0[1], sigmoidf_(bflo(gt.y)) * v0[2], sigmoidf_(bfhi(gt.y)) * v0[3],
                                  sigmoidf_(bflo(gt.z)) * v1[0], sigmoidf_(bfhi(gt.z)) * v1[1], sigmoidf_(bflo(gt.w)) * v1[2], sigmoidf_(bfhi(gt.w)) * v1[3]};
                    if (!first) { const u32x4 p = *(const u32x4*)(Mo + off);
                        o[0] += bflo(p.x); o[1] += bfhi(p.x); o[2] += bflo(p.y); o[3] += bfhi(p.y); o[4] += bflo(p.z); o[5] += bfhi(p.z); o[6] += bflo(p.w); o[7] += bfhi(p.w); }
                    u32x4 w; w.x = pk2(o[0], o[1]); w.y = pk2(o[2], o[3]); w.z = pk2(o[4], o[5]); w.w = pk2(o[6], o[7]);
                    *(u32x4*)(Mo + off) = w;
                    asm volatile("" ::: "memory");
                }
    }
};
struct EpiResid {
    static constexpr bool PERM = false, AFTER_DRAIN = false;
    const float* baseL; const float* baseC; float* outL; float* outC; const float* mod; int midx; float coef;
    __device__ __forceinline__ void operator()(const f32x4 (&acc)[2][2][4][2], const pg8::Unit& u, int wr, int wc, int fr, int fq) const {
        const bool lat = u.pm < 128;
        const float* base = lat ? baseL + (size_t)u.pm * 256 * DM : baseC + (size_t)(u.pm - 128) * 256 * DM;
        float* out = lat ? outL + (size_t)u.pm * 256 * DM : outC + (size_t)(u.pm - 128) * 256 * DM;
        const int j = lat ? (u.pm >> 4) : 8;
        const float* mv = mod + (size_t)j * 9216 + midx * 1024;
        const int row0 = wr * 64 + fr, col0 = u.pn * 256 + wc * 32 + 4 * fq;
#pragma unroll
        for (int bj = 0; bj < 2; ++bj)
#pragma unroll
            for (int n = 0; n < 2; ++n) {
                const int col = col0 + bj * 128 + n * 16;
                const f32x4 mm = *(const f32x4*)(mv + col) * coef;
#pragma unroll
                for (int ai = 0; ai < 2; ++ai)
#pragma unroll
                    for (int m = 0; m < 4; ++m) {
                        const size_t off = (size_t)(row0 + ai * 128 + m * 16) * DM + col;
                        const f32x4 bs = *(const f32x4*)(base + off);
                        *(f32x4*)(out + off) = bs + mm * acc[ai][bj][m][n];
                        if (m & 1) asm volatile("" ::: "memory");
                    }
            }
    }
};

__device__ __forceinline__ float wave_sum(float v) {
#pragma unroll
    for (int o = 1; o < 64; o <<= 1) v += __shfl_xor(v, o);
    return v;
}
__device__ __forceinline__ void conv_job(LAS unsigned char* lds, const float* W, int K, int N, bf16_t* WT, int kind, int gw, int NGW, int lane, int wave) {
    LAS float* scr = (LAS float*)(lds + wave * 9216);
    const int nblk = N / 32, nitems = (K / 64) * nblk;
    for (int item = gw; item < nitems; item += NGW) {
        const int kb = item / nblk, nb = item % nblk, k0 = 64 * kb, n0 = 32 * nb;
        const int d0 = kind == 0 ? n0 : ((n0 >> 7) * 256 + (n0 & 127) + (kind == 2 ? 128 : 0));
#pragma unroll 8
        for (int i = 0; i < 32; ++i) { const int kk = 2 * i + (lane >> 5); scr[kk * 33 + (lane & 31)] = W[(size_t)(k0 + kk) * N + n0 + (lane & 31)]; }
        asm volatile("s_waitcnt lgkmcnt(0)" ::: "memory");
        const int c = lane & 7;
#pragma unroll
        for (int j = 0; j < 4; ++j) { const int n = (lane >> 3) + 8 * j; const LAS float* s = scr + (8 * c) * 33 + n;
            u32x4 o; o.x = pk2(s[0 * 33], s[1 * 33]); o.y = pk2(s[2 * 33], s[3 * 33]); o.z = pk2(s[4 * 33], s[5 * 33]); o.w = pk2(s[6 * 33], s[7 * 33]);
            *(u32x4*)(WT + (size_t)(d0 + n) * K + k0 + 8 * c) = o; }
        asm volatile("s_waitcnt lgkmcnt(0)" ::: "memory");
    }
}
__device__ __forceinline__ void zero_rows(bf16_t* p, size_t n16  , int gtid, int gthreads) {
    for (size_t i = gtid; i < n16; i += gthreads) ((u32x4*)p)[i] = (u32x4){0u, 0u, 0u, 0u};
}
__device__ __forceinline__ void mod_gemv(LAS unsigned char* lds, const float* c, const float* cctx, const float* w_ada, const float* b_ada, float* mod, int G) {
    LAS float* sv = (LAS float*)lds;
    LAS float* part = (LAS float*)(lds + 40960);
    int tid = threadIdx.x; asm volatile("" : "+v"(tid));
    for (int i = tid; i < 9 * 1024; i += 512) { const float v = (i < 8192) ? c[i] : cctx[i - 8192]; sv[i] = v / (1.f + expf(-v)); }
    __syncthreads();
    const int col = tid & 31, kseg = tid >> 5;
    for (int item = blockIdx.x; item < 576; item += G) {
        const int l = item / 288, n0 = (item % 288) * 32;
        const float* w = w_ada + (size_t)l * 1024 * 9216 + n0 + col;
        float acc[9];
#pragma unroll
        for (int j = 0; j < 9; ++j) acc[j] = 0.f;
#pragma unroll 4
        for (int kk = 0; kk < 64; ++kk) { const int k = kseg * 64 + kk; const float wv = w[(size_t)k * 9216];
#pragma unroll
            for (int j = 0; j < 9; ++j) acc[j] += sv[j * 1024 + k] * wv; }
#pragma unroll
        for (int j = 0; j < 9; ++j) part[(kseg * 9 + j) * 32 + col] = acc[j];
        __syncthreads();
        if (tid < 288) { const int j = tid >> 5; float s = 0.f;
#pragma unroll
            for (int ks = 0; ks < 16; ++ks) s += part[(ks * 9 + j) * 32 + col];
            mod[((size_t)l * 9 + j) * 9216 + n0 + col] = s + b_ada[l * 9216 + n0 + col]; }
        __syncthreads();
    }
}
__device__ __forceinline__ void make_tables(const float* a_re, const float* a_im, const float* log_dt, const float* b_re, const float* b_im, const float* c_re, const float* c_im,
                                            float2* rope, float2* LAM, float2* LAMT, float2* BB, bf16_t* CT, int gtid, int gthreads) {
    for (int i = gtid; i < 1024; i += gthreads) { const int pos = i >> 4, j = i & 15; const float inv = powf(10000.f, -(float)j / 16.f); const float ang = (float)pos * inv; rope[i] = make_float2(cosf(ang), sinf(ang)); }
    for (int i = gtid; i < 2 * 2 * NGRP * 64; i += gthreads) {
        const float are = a_re[i], aim = a_im[i], dt = expf(log_dt[i >> 6]);
        const float mg = expf(are * dt), lbr = mg * cosf(aim * dt), lbi = mg * sinf(aim * dt);
        const float d2 = are * are + aim * aim, nr = lbr - 1.f, ni = lbi;
        const float cr = (nr * are + ni * aim) / d2, ci = (ni * are - nr * aim) / d2;
        LAM[i] = make_float2(lbr, lbi);
        float pr = lbr, pi = lbi;
#pragma unroll
        for (int s = 0; s < 6; ++s) { const float t = pr * pr - pi * pi; pi = 2.f * pr * pi; pr = t; }
        LAMT[i] = make_float2(pr, pi);
        for (int k = 0; k < 16; ++k) { const float br = b_re[(size_t)i * 16 + k], bi = b_im[(size_t)i * 16 + k]; BB[(size_t)i * 16 + k] = make_float2(cr * br - ci * bi, cr * bi + ci * br); }
    }
    for (int i = gtid; i < 2 * 2 * NGRP * 4 * 64 * 8; i += gthreads) {
        const int e = i & 7, lane = (i >> 3) & 63, ks = (i >> 9) & 3, rest = i >> 11;
        const int n = lane & 15, g4 = lane >> 4, k = 32 * ks + 8 * g4 + e, p = k >> 1;
        const size_t ci = ((size_t)rest * 16 + n) * 64 + p;
        CT[i] = (bf16_t)f2bf((k & 1) ? -c_im[ci] : c_re[ci]);
    }
}
__device__ __forceinline__ void norm_phase(const float* srcL, const float* srcC, const float* g, const float* mod, int ishift, int iscale, bf16_t* H, int nrows, int gw, int NGW, int lane) {
    for (int r = gw; r < nrows; r += NGW) {
        const float* xr = r < MLAT ? srcL + (size_t)r * DM : srcC + (size_t)(r - MLAT) * DM;
        const int j = r < MLAT ? (r >> 12) : 8;
        const float* sh = mod + (size_t)j * 9216 + ishift * 1024; const float* sc = mod + (size_t)j * 9216 + iscale * 1024;
        f32x4 v[4]; float s = 0.f;
#pragma unroll
        for (int q = 0; q < 4; ++q) { v[q] = ((const f32x4*)xr)[lane + 64 * q]; s += (v[q].x * v[q].x + v[q].y * v[q].y) + (v[q].z * v[q].z + v[q].w * v[q].w); }
        const float rstd = rsqrtf(wave_sum(s) * (1.f / DM) + 1e-6f);
#pragma unroll
        for (int q = 0; q < 4; ++q) {
            const f32x4 gg = ((const f32x4*)g)[lane + 64 * q], s1 = ((const f32x4*)sc)[lane + 64 * q], s0 = ((const f32x4*)sh)[lane + 64 * q];
            const f32x4 o = (v[q] * rstd * gg) * (s1 + 1.f) + s0;
            u32x2 w; w.x = pk2(o.x, o.y); w.y = pk2(o.z, o.w);
            ((u32x2*)(H + (size_t)r * DM))[lane + 64 * q] = w;
        }
    }
}
__device__ __forceinline__ void final_norm(float* out, const float* g, int gw, int NGW, int lane) {
    for (int r = gw; r < MLAT; r += NGW) {
        f32x4* xr = (f32x4*)(out + (size_t)r * DM);
        f32x4 v[4]; float s = 0.f;
#pragma unroll
        for (int q = 0; q < 4; ++q) { v[q] = xr[lane + 64 * q]; s += (v[q].x * v[q].x + v[q].y * v[q].y) + (v[q].z * v[q].z + v[q].w * v[q].w); }
        const float rstd = rsqrtf(wave_sum(s) * (1.f / DM) + 1e-6f);
#pragma unroll
        for (int q = 0; q < 4; ++q) xr[lane + 64 * q] = v[q] * rstd * ((const f32x4*)g)[lane + 64 * q];
    }
}

template <bool FINAL>
__device__ __forceinline__ void ssm_chunks(LAS unsigned char* lds, int l, bf16_t* z, const float2* LAM, const float2* BB, const bf16_t* CT, float2* CB, const float* dvec, int gw, int NGW, int lane, int wave, bool skip_ctx = false) {
    LAS float* U = (LAS float*)(lds + wave * 9216);
    LAS unsigned char* Sb = lds + wave * 9216 + 4096;
    for (int task = gw; task < NBATCH * NGRP * NCH; task += NGW) {
        const int grp = task % NGRP, tc = (task / NGRP) % NCH, b = task / (NCH * NGRP);
        const int row0 = tc < 4 ? MLAT + b * CTXL + tc * 64 : b * SEQ + (tc - 4) * 64;
        if (FINAL && skip_ctx && tc < 4) continue;
        {   const bf16_t* up = z + (size_t)(row0 + lane) * LDZ + ZU + grp * 16;
            const u32x4 r0 = *(const u32x4*)up, r1 = *(const u32x4*)(up + 8);
            LAS f32x4* ud = (LAS f32x4*)(U + lane * 16);
            ud[0] = (f32x4){bflo(r0.x), bfhi(r0.x), bflo(r0.y), bfhi(r0.y)}; ud[1] = (f32x4){bflo(r0.z), bfhi(r0.z), bflo(r0.w), bfhi(r0.w)};
            ud[2] = (f32x4){bflo(r1.x), bfhi(r1.x), bflo(r1.y), bfhi(r1.y)}; ud[3] = (f32x4){bflo(r1.z), bfhi(r1.z), bflo(r1.w), bfhi(r1.w)};
        }
        f32x4 yacc[4];
#pragma unroll
        for (int q = 0; q < 4; ++q) yacc[q] = (f32x4){0.f, 0.f, 0.f, 0.f};
        for (int d = 0; d < 2; ++d) {
            const int sc = d == 0 ? tc : (tc < 4 ? 3 - tc : 71 - tc);
            const int pg = ((l * 2 + d) * NGRP + grp);
            const int pidx = pg * 64 + lane;
            const float2 lam = LAM[pidx];
            f32x4 bbv[8];
#pragma unroll
            for (int q = 0; q < 8; ++q) bbv[q] = ((const f32x4*)(BB + (size_t)pidx * 16))[q];
            bf16x8 cf[4];
            if (FINAL) {
#pragma unroll
                for (int ks = 0; ks < 4; ++ks) cf[ks] = *(const bf16x8*)(CT + ((size_t)(pg * 4 + ks) * 64 + lane) * 8);
            }
            const size_t cbi = ((((size_t)b * 2 + d) * NGRP + grp) * NCH + sc) * 64 + lane;
            float sr = 0.f, si = 0.f;
            if (FINAL) { const float2 c0 = CB[cbi]; sr = c0.x; si = c0.y; }
#pragma unroll
            for (int sub = 0; sub < 4; ++sub) {
                const int sb = d == 0 ? sub : 3 - sub;
#pragma unroll 4
                for (int tt = 0; tt < 16; ++tt) {
                    const int ti = d == 0 ? tt : 15 - tt;
                    const LAS f32x4* ur = (const LAS f32x4*)(U + (sb * 16 + ti) * 16);
                    float br = 0.f, bi = 0.f;
#pragma unroll
                    for (int q = 0; q < 4; ++q) { const f32x4 uu = ur[q];
                        br += bbv[2 * q].x * uu.x; bi += bbv[2 * q].y * uu.x; br += bbv[2 * q].z * uu.y; bi += bbv[2 * q].w * uu.y;
                        br += bbv[2 * q + 1].x * uu.z; bi += bbv[2 * q + 1].y * uu.z; br += bbv[2 * q + 1].z * uu.w; bi += bbv[2 * q + 1].w * uu.w; }
                    const float nr = lam.x * sr - lam.y * si + br, ni = lam.x * si + lam.y * sr + bi;
                    sr = nr; si = ni;
                    if (FINAL) *(LAS unsigned*)(Sb + ti * 272 + lane * 4) = pk2(sr, si);
                }
                if (FINAL) {
#pragma unroll
                    for (int ks = 0; ks < 4; ++ks) {
                        const bf16x8 a = *(const LAS bf16x8*)(Sb + (lane & 15) * 272 + (32 * ks + 8 * (lane >> 4)) * 2);
                        if (sb == 0) yacc[0] = __builtin_amdgcn_mfma_f32_16x16x32_bf16(a, cf[ks], yacc[0], 0, 0, 0);
                        else if (sb == 1) yacc[1] = __builtin_amdgcn_mfma_f32_16x16x32_bf16(a, cf[ks], yacc[1], 0, 0, 0);
                        else if (sb == 2) yacc[2] = __builtin_amdgcn_mfma_f32_16x16x32_bf16(a, cf[ks], yacc[2], 0, 0, 0);
                        else yacc[3] = __builtin_amdgcn_mfma_f32_16x16x32_bf16(a, cf[ks], yacc[3], 0, 0, 0);
                    }
                }
            }
            if (!FINAL) CB[cbi] = make_float2(sr, si);
        }
        if (FINAL) {
            const int n = lane & 15, g4 = lane >> 4; const float dv = dvec[grp * 16 + n];
#pragma unroll
            for (int sb = 0; sb < 4; ++sb)
#pragma unroll
                for (int j = 0; j < 4; ++j) { const int tok = sb * 16 + 4 * g4 + j; const float y = yacc[sb][j] + dv * U[tok * 16 + n];
                    z[(size_t)(row0 + tok) * LDZ + ZU + grp * 16 + n] = (bf16_t)f2bf(gelu_tanh(y)); }
        }
        asm volatile("s_waitcnt lgkmcnt(0)" ::: "memory");
    }
}
__device__ __forceinline__ void ssm_carry(int l, const float2* LAMT, float2* CB, int gtid) {
    if (gtid < NBATCH * 2 * NGRP * 64) {
        const int p = gtid & 63, grp = (gtid >> 6) % NGRP, d = (gtid / (64 * NGRP)) & 1;
        const float2 lt = LAMT[((l * 2 + d) * NGRP + grp) * 64 + p];
        float2* base = CB + (size_t)(gtid >> 6) * NCH * 64 + p;
        float cr = 0.f, ci = 0.f;
#pragma unroll 4
        for (int sc = 0; sc < NCH; ++sc) { const float2 t = base[sc * 64]; base[sc * 64] = make_float2(cr, ci);
            const float nr = lt.x * cr - lt.y * ci + t.x, ni = lt.x * ci + lt.y * cr + t.y; cr = nr; ci = ni; }
    }
}

__device__ __forceinline__ void attn_phase(LAS unsigned char* lds, bool ctx_out, bf16_t* z, const float2* rope, const float* sink, const float* rpb, int G, bf16_t* dummy = nullptr) {
    int tid = threadIdx.x; asm volatile("" : "+v"(tid));
    const int lane = tid & 63, wave = tid >> 6, half = wave >> 2, wq = wave & 3, n = lane & 15, g4 = lane >> 4;
    LAS f32x2* ropeL = (LAS f32x2*)(lds + 73728);
    LAS float* rpbL = (LAS float*)(lds + 81920);
    for (int i = tid; i < 1024; i += 512) { const float2 rv = rope[i]; ropeL[i] = (f32x2){rv.x, rv.y}; }
    __syncthreads();
    const int nNA = 2048, nGQ = 2048, nCX = ctx_out ? 256 : 0, total = nNA + nGQ + nCX;
    const int tt = tid & 255, key = tt >> 2, cp = tt & 3;
    const int vkp = tt & 31, vch = 2 * (tt >> 6) + ((tt >> 5) & 1);
    for (int item = blockIdx.x; item < total; item += G) {
        int type, hi;
        if (item < nNA) { type = 1; hi = item * 2 + half; }
        else if (item < nNA + nGQ) { type = 0; hi = (item - nNA) * 2 + half; }
        else { const int r_ = item - nNA - nGQ; if (r_ < 128) { type = 2; hi = r_ * 2 + half; } else { type = 3; hi = (r_ - 128) * 2 + half; } }
        int b, h, qrow0, qcol, kcol, vcol, ntiles, q0 = 0, t_lo = 0, r = 0, rs = 0;
        float mrun = -1e30f, lsum = 0.f;
        if (type == 0) { const int kvh = hi & 1, qc = (hi >> 1) & 255; b = hi >> 9; h = kvh * 4 + wq; q0 = qc * 16; qrow0 = b * SEQ + q0; qcol = ZGQ + h * 64; kcol = ZGK + kvh * 64; vcol = ZGV + kvh * 64; ntiles = 10; t_lo = (q0 - 128) >> 6; mrun = sink[h] * LOG2E; lsum = g4 == 0 ? 1.f : 0.f; }
        else if (type == 1) { h = hi & 7; r = (hi >> 3) & 63; b = hi >> 9; qrow0 = b * SEQ + r * 64 + wq * 16; qcol = ZNQ + h * 64; kcol = ZNK + h * 64; vcol = ZNV + h * 64; ntiles = 12; rs = min(max(r - 4, 0), 56); }
        else if (type == 2) { const int kvh = hi & 1, qc = (hi >> 1) & 15; b = hi >> 5; h = kvh * 4 + wq; qrow0 = MLAT + b * CTXL + qc * 16; qcol = ZGQ + h * 64; kcol = ZGK + kvh * 64; vcol = ZGV + kvh * 64; ntiles = 4; mrun = sink[h] * LOG2E; lsum = g4 == 0 ? 1.f : 0.f; }
        else { h = hi & 7; const int qc = (hi >> 3) & 3; b = hi >> 5; qrow0 = MLAT + b * CTXL + qc * 64 + wq * 16; qcol = ZNQ + h * 64; kcol = ZNK + h * 64; vcol = ZNV + h * 64; ntiles = 4; }
        if (type == 1) { for (int i = tt; i < 465; i += 256) rpbL[half * 480 + i] = rpb[h * 465 + i] * LOG2E; }
        unsigned vmask = 0u;
        if (type == 1) { const int c_ = 16 * wq + n, cs_ = min(max(c_ - 8, 0), 48);
#pragma unroll
            for (int q_ = 0; q_ < 16; ++q_) { const int kc_ = 16 * (q_ >> 2) + 4 * g4 + (q_ & 3); if (kc_ >= cs_ && kc_ < cs_ + 16) vmask |= 1u << q_; } }
        bf16x8 qf[2];
        {   const bf16_t* qp = z + (size_t)(qrow0 + n) * LDZ + qcol;
#pragma unroll
            for (int ks = 0; ks < 2; ++ks) {
                const u32x4 raw = *(const u32x4*)(qp + 32 * ks + 8 * g4);
                float f[8] = {bflo(raw.x), bfhi(raw.x), bflo(raw.y), bfhi(raw.y), bflo(raw.z), bfhi(raw.z), bflo(raw.w), bfhi(raw.w)};
                if (type == 0) {
                    const u32x4 r2 = *(const u32x4*)(qp + 32 * ks + 8 * (g4 ^ 2));
                    const float f2[8] = {bflo(r2.x), bfhi(r2.x), bflo(r2.y), bfhi(r2.y), bflo(r2.z), bfhi(r2.z), bflo(r2.w), bfhi(r2.w)};
                    const int pos = ks == 0 ? ((q0 + n) >> 6) : ((q0 + n) & 63);
#pragma unroll
                    for (int e = 0; e < 8; ++e) { const f32x2 cs = ropeL[pos * 16 + 8 * (g4 & 1) + e]; f[e] = g4 < 2 ? f[e] * cs.x - f2[e] * cs.y : f2[e] * cs.y + f[e] * cs.x; }
                }
                const float qs = 0.125f * LOG2E;
                u32x4 w; w.x = pk2(f[0] * qs, f[1] * qs); w.y = pk2(f[2] * qs, f[3] * qs); w.z = pk2(f[4] * qs, f[5] * qs); w.w = pk2(f[6] * qs, f[7] * qs);
                qf[ks] = __builtin_bit_cast(bf16x8, w);
            }
        }
        f32x4 oacc[4];
#pragma unroll
        for (int q = 0; q < 4; ++q) oacc[q] = (f32x4){0.f, 0.f, 0.f, 0.f};
        u32x4 kr0, kr1, vr0, vr1, kp0, kp1; int skpos = 0; bool srope = false;
        kp0 = kp1 = (u32x4){0u, 0u, 0u, 0u};
#define ATT_LOAD(t_) do { int krow_; srope = false; skpos = 0; \
            if ((t_) < 4) krow_ = MLAT + b * CTXL + (t_) * 64 + key; \
            else if (type == 0) { skpos = 64 * (t_lo + (t_) - 4) + key; krow_ = b * SEQ + min(max(skpos, 0), SEQ - 1); srope = true; } \
            else krow_ = b * SEQ + (rs + (t_) - 4) * 64 + key; \
            const bf16_t* kp_ = z + (size_t)krow_ * LDZ + kcol + 16 * cp; \
            kr0 = *(const u32x4*)kp_; kr1 = *(const u32x4*)(kp_ + 8); \
            { int va_, vb_; if ((t_) < 4) { va_ = MLAT + b * CTXL + (t_) * 64 + 2 * vkp; vb_ = va_ + 1; } \
              else if (type == 0) { const int p0_ = 64 * (t_lo + (t_) - 4) + 2 * vkp; va_ = b * SEQ + min(max(p0_, 0), SEQ - 1); vb_ = b * SEQ + min(max(p0_ + 1, 0), SEQ - 1); } \
              else { va_ = b * SEQ + (rs + (t_) - 4) * 64 + 2 * vkp; vb_ = va_ + 1; } \
              vr0 = *(const u32x4*)(z + (size_t)va_ * LDZ + vcol + 8 * vch); vr1 = *(const u32x4*)(z + (size_t)vb_ * LDZ + vcol + 8 * vch); } \
            if (srope) { const bf16_t* k2_ = z + (size_t)krow_ * LDZ + kcol + 16 * (cp ^ 1); kp0 = *(const u32x4*)k2_; kp1 = *(const u32x4*)(k2_ + 8); } } while (0)
#define ATT_STORE(buf_) do { LAS unsigned char* Kd_ = lds + ((buf_) * 2 + half) * 18432; LAS unsigned char* Vd_ = Kd_ + 9216; \
            if (srope) { const int kc_ = min(max(skpos, 0), SEQ - 1); const int pos_ = cp < 2 ? (kc_ >> 6) : (kc_ & 63); \
                float a_[16] = {bflo(kr0.x), bfhi(kr0.x), bflo(kr0.y), bfhi(kr0.y), bflo(kr0.z), bfhi(kr0.z), bflo(kr0.w), bfhi(kr0.w), bflo(kr1.x), bfhi(kr1.x), bflo(kr1.y), bfhi(kr1.y), bflo(kr1.z), bfhi(kr1.z), bflo(kr1.w), bfhi(kr1.w)}; \
                const float p_[16] = {bflo(kp0.x), bfhi(kp0.x), bflo(kp0.y), bfhi(kp0.y), bflo(kp0.z), bfhi(kp0.z), bflo(kp0.w), bfhi(kp0.w), bflo(kp1.x), bfhi(kp1.x), bflo(kp1.y), bfhi(kp1.y), bflo(kp1.z), bfhi(kp1.z), bflo(kp1.w), bfhi(kp1.w)}; \
                _Pragma("unroll") for (int e_ = 0; e_ < 16; ++e_) { const f32x2 cs_ = ropeL[pos_ * 16 + e_]; a_[e_] = (cp & 1) == 0 ? a_[e_] * cs_.x - p_[e_] * cs_.y : p_[e_] * cs_.y + a_[e_] * cs_.x; } \
                kr0.x = pk2(a_[0], a_[1]); kr0.y = pk2(a_[2], a_[3]); kr0.z = pk2(a_[4], a_[5]); kr0.w = pk2(a_[6], a_[7]); kr1.x = pk2(a_[8], a_[9]); kr1.y = pk2(a_[10], a_[11]); kr1.z = pk2(a_[12], a_[13]); kr1.w = pk2(a_[14], a_[15]); } \
            *(LAS u32x4*)(Kd_ + key * 144 + cp * 32) = kr0; *(LAS u32x4*)(Kd_ + key * 144 + cp * 32 + 16) = kr1; \
            { const unsigned va4_[4] = {vr0.x, vr0.y, vr0.z, vr0.w}; const unsigned vb4_[4] = {vr1.x, vr1.y, vr1.z, vr1.w}; \
              _Pragma("unroll") for (int e_ = 0; e_ < 4; ++e_) { \
                *(LAS unsigned*)(Vd_ + (8 * vch + 2 * e_) * 144 + vkp * 4) = (va4_[e_] & 0xffffu) | (vb4_[e_] << 16); \
                *(LAS unsigned*)(Vd_ + (8 * vch + 2 * e_ + 1) * 144 + vkp * 4) = (va4_[e_] >> 16) | (vb4_[e_] & 0xffff0000u); } } } while (0)
        ATT_LOAD(0); ATT_STORE(0);
        __syncthreads();
        for (int t = 0; t < ntiles; ++t) {
            if (t + 1 < ntiles) ATT_LOAD(t + 1);
            const LAS unsigned char* Kb = lds + ((t & 1) * 2 + half) * 18432; const LAS unsigned char* Vb = Kb + 9216;
            int need = 0xF;
            if (t >= 4) {
                if (type == 1) need = (wq == 0) ? 0x3 : (wq == 1) ? 0x7 : (wq == 2) ? 0xE : 0xC;
                else { const int kb_ = 64 * (t_lo + t - 4); need = 0;
#pragma unroll
                    for (int kt = 0; kt < 4; ++kt) { const int k0_ = kb_ + 16 * kt; if (k0_ + 15 >= q0 - 128 && k0_ <= q0 + 143 && k0_ >= 0 && k0_ < SEQ) need |= 1 << kt; } }
                need = __builtin_amdgcn_readfirstlane(need);
            }
            f32x4 s[4];
#pragma unroll
            for (int kt = 0; kt < 4; ++kt) {
                if ((need >> kt) & 1) { s[kt] = (f32x4){0.f, 0.f, 0.f, 0.f};
#pragma unroll
                    for (int ks = 0; ks < 2; ++ks) { const bf16x8 a = *(const LAS bf16x8*)(Kb + (16 * kt + n) * 144 + 64 * ks + 16 * g4); s[kt] = __builtin_amdgcn_mfma_f32_16x16x32_bf16(a, qf[ks], s[kt], 0, 0, 0); } }
                else s[kt] = (f32x4){-1e30f, -1e30f, -1e30f, -1e30f};
            }
            if (t >= 4) {
                const int lt = t - 4;
                if (type == 0) { const int kb0 = 64 * (t_lo + lt) + 4 * g4, qpos = q0 + n; const int lo_ = max(qpos - 128, 0), span_ = min(qpos + 128, SEQ - 1) - lo_;
#pragma unroll
                    for (int kt = 0; kt < 4; ++kt) if ((need >> kt) & 1) {
#pragma unroll
                        for (int j = 0; j < 4; ++j) { const int kpos = kb0 + 16 * kt + j; const bool ok = (unsigned)(kpos - lo_) <= (unsigned)span_; s[kt][j] = ok ? s[kt][j] : -1e30f; } } }
                else { const LAS float* rb = rpbL + half * 480 + (rs + lt - r + 7) * 31 + 15 - (16 * wq + n) + 4 * g4;
#pragma unroll
                    for (int kt = 0; kt < 4; ++kt) if ((need >> kt) & 1) {
#pragma unroll
                        for (int j = 0; j < 4; ++j) { const bool ok = (vmask >> (4 * kt + j)) & 1; const float bias = rb[16 * kt + j]; s[kt][j] = ok ? s[kt][j] + bias : -1e30f; } } }
            }
            float mx = s[0][0];
#pragma unroll
            for (int kt = 0; kt < 4; ++kt)
#pragma unroll
                for (int j = 0; j < 4; ++j) mx = fmaxf(mx, s[kt][j]);
            mx = fmaxf(mx, __shfl_xor(mx, 16)); mx = fmaxf(mx, __shfl_xor(mx, 32));
            const float mnew = fmaxf(mrun, mx), alpha = __builtin_amdgcn_exp2f(mrun - mnew); mrun = mnew;
            float psum = 0.f;
#pragma unroll
            for (int kt = 0; kt < 4; ++kt) {
                if ((need >> kt) & 1) {
#pragma unroll
                    for (int j = 0; j < 4; ++j) { const float p = __builtin_amdgcn_exp2f(s[kt][j] - mnew); s[kt][j] = p; psum += p; } }
                else s[kt] = (f32x4){0.f, 0.f, 0.f, 0.f};
            }
            lsum = lsum * alpha + psum;
#pragma unroll
            for (int q = 0; q < 4; ++q) oacc[q] = oacc[q] * alpha;
            bf16x8 pb[2];
#pragma unroll
            for (int ks = 0; ks < 2; ++ks) { u32x4 w; w.x = pk2(s[2 * ks][0], s[2 * ks][1]); w.y = pk2(s[2 * ks][2], s[2 * ks][3]); w.z = pk2(s[2 * ks + 1][0], s[2 * ks + 1][1]); w.w = pk2(s[2 * ks + 1][2], s[2 * ks + 1][3]); pb[ks] = __builtin_bit_cast(bf16x8, w); }
#pragma unroll
            for (int dt = 0; dt < 4; ++dt)
#pragma unroll
                for (int ks = 0; ks < 2; ++ks) if ((need >> (2 * ks)) & 3) { const LAS unsigned char* vp = Vb + (16 * dt + n) * 144 + (32 * ks + 4 * g4) * 2;
                    const u32x2 lo = *(const LAS u32x2*)vp, hi2 = *(const LAS u32x2*)(vp + 32);
                    const u32x4 av = (u32x4){lo.x, lo.y, hi2.x, hi2.y};
                    oacc[dt] = __builtin_amdgcn_mfma_f32_16x16x32_bf16(__builtin_bit_cast(bf16x8, av), pb[ks], oacc[dt], 0, 0, 0); }
            if (t + 1 < ntiles) ATT_STORE((t + 1) & 1);
            __syncthreads();
        }
#undef ATT_LOAD
#undef ATT_STORE
        float ltot = lsum + __shfl_xor(lsum, 16); ltot += __shfl_xor(ltot, 32);
        const float inv = 1.f / ltot;
        bf16_t* op = z + (size_t)(qrow0 + n) * LDZ + qcol + 4 * g4;
        if (dummy) op = dummy + (size_t)(qrow0 + n) * 1024 + ((type & 1) ? 512 : 0) + h * 64 + 4 * g4;
#pragma unroll
        for (int dt = 0; dt < 4; ++dt) { u32x2 w; w.x = pk2(oacc[dt][0] * inv, oacc[dt][1] * inv); w.y = pk2(oacc[dt][2] * inv, oacc[dt][3] * inv); *(u32x2*)(op + 16 * dt) = w; }
    }
}

#define XB_TMO      128
#define XB_XCNT(j)  (256  + 64 * (j))
#define XB_XSUB(j)  (1280 + 64 * (j))
#define XB_XGEN(j)  (2304 + 64 * (j))
#define XB_TOP      3328
#define XB_TOPGEN   3392
#define XCD_BAR_WORDS 3456
#define XB_SPIN_CAP (1u << 18)

__device__ __forceinline__ unsigned xb_ld(unsigned* p)              { return __hip_atomic_load(p, __ATOMIC_RELAXED, __HIP_MEMORY_SCOPE_AGENT); }
__device__ __forceinline__ unsigned xb_add(unsigned* p, unsigned v) { return __hip_atomic_fetch_add(p, v, __ATOMIC_RELAXED, __HIP_MEMORY_SCOPE_AGENT); }
__device__ __forceinline__ unsigned xb_xcc_id() { return (unsigned)__builtin_amdgcn_s_getreg((3 << 11) | 20) & 0xFu; }
#define XB_SPIN(cond, bar) do { unsigned _sp = 0; while (cond) { __builtin_amdgcn_s_sleep(1); \
    if ((++_sp & 255u) == 0u) { if (xb_ld(&(bar)[XB_TMO])) break; if (_sp > XB_SPIN_CAP) { atomicAdd(&(bar)[XB_TMO], 1u); break; } } } } while (0)

struct XcdBarrier {
    unsigned* bar; unsigned x;
    volatile LAS unsigned* st;
};

__device__ __forceinline__ XcdBarrier xcd_barrier_post(unsigned* bar, volatile LAS unsigned* st) {
    XcdBarrier b; b.bar = bar; b.x = xb_xcc_id(); b.st = st;
    if (threadIdx.x == 0) (void)xb_add(&bar[XB_XCNT(b.x)], 1u);
    return b;
}
__device__ __forceinline__ void xcd_barrier_complete(unsigned* bar, unsigned x, unsigned& nloc, unsigned& nx) {
    const unsigned G = gridDim.x * gridDim.y * gridDim.z;
    unsigned sum, cnt, mine, sp = 0u;
    for (;;) {
        sum = 0u; cnt = 0u; mine = 0u;
#pragma unroll
        for (unsigned j = 0; j < 16; ++j) { const unsigned c = xb_ld(&bar[XB_XCNT(j)]); sum += c; cnt += (c > 0u) ? 1u : 0u; mine = (j == x) ? c : mine; }
        if (sum == G) break;
        __builtin_amdgcn_s_sleep(1);
        if ((++sp & 255u) == 0u) { if (xb_ld(&bar[XB_TMO])) break; if (sp > XB_SPIN_CAP) { atomicAdd(&bar[XB_TMO], 1u); break; } }
    }
    nloc = mine > 0u ? mine : 1u; nx = cnt > 0u ? cnt : 1u;
}

__device__ __forceinline__ void xcd_barrier(const XcdBarrier& b) {
    asm volatile("s_waitcnt vmcnt(0)" ::: "memory");
    __syncthreads();
    if (threadIdx.x == 0) {
        unsigned* bar = b.bar;
        __builtin_amdgcn_s_waitcnt(0);
        unsigned nloc = b.st[0], nx = b.st[1];
        if (nloc == 0u) { xcd_barrier_complete(bar, b.x, nloc, nx); b.st[0] = nloc; b.st[1] = nx; }
        const unsigned old = xb_add(&bar[XB_XSUB(b.x)], 1u);
        const unsigned gen = old / nloc;
        if (old + 1u == (gen + 1u) * nloc) {
            __builtin_amdgcn_fence(__ATOMIC_RELEASE, "agent");
            asm volatile("s_waitcnt vmcnt(0)" ::: "memory");
            const unsigned og = xb_add(&bar[XB_TOP], 1u);
            const unsigned tg = og / nx;
            if (og + 1u == (tg + 1u) * nx) xb_add(&bar[XB_TOPGEN], 1u);
            else XB_SPIN(xb_ld(&bar[XB_TOPGEN]) == tg, bar);
            __builtin_amdgcn_fence(__ATOMIC_ACQUIRE, "agent");
            xb_add(&bar[XB_XGEN(b.x)], 1u);
            asm volatile("s_waitcnt vmcnt(0)" ::: "memory");
        } else {
            XB_SPIN(xb_ld(&bar[XB_XGEN(b.x)]) == gen, bar);
            __builtin_amdgcn_fence(__ATOMIC_ACQUIRE, "agent");
            asm volatile("s_waitcnt vmcnt(0)" ::: "memory");
        }
    }
    __syncthreads();
}

#if EXP_SYNC
#define GSYNC() do { xcd_barrier(xbar); xcd_barrier(xbar); } while (0)
#else
#define GSYNC() xcd_barrier(xbar)
#endif
constexpr size_t WS_BAR = 768 * 1024;
struct Args { const float* in[30]; float* out; unsigned char* ws; };
__device__ __forceinline__ const float* karg(int i) { unsigned off = 8u * (unsigned)i; asm volatile("" : "+s"(off));
    const __attribute__((address_space(4))) char* p = (const __attribute__((address_space(4))) char*)__builtin_amdgcn_kernarg_segment_ptr();
    return *(const float* const __attribute__((address_space(4)))*)(p + off); }

#ifdef NO_GEMM
#define GEMM_CALL(EPI, Aptr, lda_, Btptr, M_, N_, K_, Eobj) do { (void)(Eobj); } while (0)
#else
#define GEMM_CALL(EPI, Aptr, lda_, Btptr, M_, N_, K_, Eobj) do { pg8::Gemm g_{(const bf16_t*)(Aptr), (const bf16_t*)(Btptr), (M_), (N_), (K_), (lda_), (K_)}; pg8::StaticOrder S_; S_.init((M_), (N_), G, (int)blockIdx.x); \
        pg8::gemm_phase<EPI, pg8::StaticOrder, true, true>(lds, g_, S_, Eobj); } while (0)
#endif

#define CONV(W, K, N, WT, kind) do { FRESH_IDS; conv_job(lds, (W), (K), (N), (WT), (kind), gw, NGW, lane, wave); } while (0)
#define FFN_CONV(l_, f_) do { const float* wg_ = karg(7 + 3 * (f_)) + (size_t)(l_) * DM * DFF; const float* wu_ = karg(8 + 3 * (f_)) + (size_t)(l_) * DM * DFF; const float* wd_ = karg(9 + 3 * (f_)) + (size_t)(l_) * DFF * DM; \
        CONV(wg_, DM, DFF, slA, 1); CONV(wu_, DM, DFF, slA, 2); CONV(wd_, DFF, DM, slB, 0); } while (0)


#define FRESH_IDS int tid_ = threadIdx.x; asm volatile("" : "+v"(tid_)); const int lane = tid_ & 63; const int wave = __builtin_amdgcn_readfirstlane(tid_ >> 6); const int gw = blockIdx.x * 8 + wave; const int gtid = blockIdx.x * 512 + tid_; (void)lane; (void)wave; (void)gw; (void)gtid;
template <int l>
__device__ __forceinline__ void layer_body(const Args& args, LAS unsigned char* lds, const XcdBarrier& xbar, const int G, const int NGW, const int gthreads) {
    unsigned char* ws = (unsigned char*)karg(31);
    float* mod = (float*)(ws + WS_MOD); float2* rope = (float2*)(ws + WS_ROPE); float2* LAM = (float2*)(ws + WS_LAM); float2* LAMT = (float2*)(ws + WS_LAMT);
    float2* BB = (float2*)(ws + WS_BB); bf16_t* CT = (bf16_t*)(ws + WS_CT); float2* CB = (float2*)(ws + WS_CB); float* xc = (float*)(ws + WS_XC);
    bf16_t* slA = (bf16_t*)(ws + WS_SLA); bf16_t* slB = (bf16_t*)(ws + WS_SLB); bf16_t* slC = (bf16_t*)(ws + WS_SLC);
    bf16_t* H = (bf16_t*)(ws + WS_H); bf16_t* Z = (bf16_t*)(ws + WS_Z); bf16_t* HID = Z; bf16_t* YS = H;
    const float* x = karg(0); const float* ctx = karg(2); float* out = (float*)karg(30);
    const float* norm_g = karg(6);
    {
        const bool ctx_out = (l == 0);
        const float* srcL = l == 0 ? x : out; const float* srcC = l == 0 ? ctx : xc;
        const float* modl = mod + (size_t)l * 9 * 9216;
        const float* gl = norm_g + (size_t)l * 3 * DM;
        if (l == 1) { FFN_CONV(1, 0); }
        { FRESH_IDS; norm_phase(srcL, srcC, gl, modl, 0, 1, H, MALL, gw, NGW, lane); }
        GSYNC();
        { EpiSwiglu E{HID, DFF}; GEMM_CALL(EpiSwiglu, H, DM, slA, MALL, 2 * DFF, DM, E); }
#if EXP_G1
        GSYNC();
        { EpiSwiglu E{HID, DFF}; GEMM_CALL(EpiSwiglu, H, DM, slA, MALL, 2 * DFF, DM, E); }
#endif
        GSYNC();
        { EpiResid E{srcL, srcC, out, xc, modl, 2, 0.5f}; GEMM_CALL(EpiResid, HID, DFF, slB, MALL, DM, DFF, E); }
        GSYNC();
        CONV(karg(13) + (size_t)l * DM * NIN, DM, NIN, slA, 0);
        { FRESH_IDS; zero_rows(slA + (size_t)NIN * DM, (size_t)(LDZ - NIN) * DM * 2 / 16, gtid, gthreads); }
        CONV(karg(22) + (size_t)l * 384 * 384, 384, 384, slC + SC_GLU, 0);
        { FRESH_IDS; zero_rows(slC + SC_GLU + 384 * 384, (size_t)128 * 384 * 2 / 16, gtid, gthreads); }
        CONV(karg(25) + (size_t)l * 384 * DM, 384, DM, slC + SC_PSSM, 0);
        CONV(karg(26) + (size_t)l * 512 * DM, 512, DM, slC + SC_PGQA, 0);
        CONV(karg(27) + (size_t)l * 512 * DM, 512, DM, slC + SC_PNA, 0);
        CONV(karg(28) + (size_t)l * DM * DM, DM, DM, slC + SC_OUT, 0);
        { FRESH_IDS; norm_phase(out, xc, gl + DM, modl, 3, 4, H, MALL, gw, NGW, lane); }
        GSYNC();
        if constexpr (l == 1) { EpiStore E{Z, LDZ}; pg8::Gemm g_{(const bf16_t*)H, (const bf16_t*)slA, MALL, LDZ, DM, DM, DM}; pg8::G3L1Order S_; S_.init(MLAT, LDZ, G, (int)blockIdx.x);
            pg8::gemm_phase<EpiStore, pg8::G3L1Order, true, true>(lds, g_, S_, E); }
        else { EpiStore E{Z, LDZ}; GEMM_CALL(EpiStore, H, DM, slA, MALL, LDZ, DM, E); }
        GSYNC();
#ifndef NO_SSM
        { FRESH_IDS; ssm_chunks<false>(lds, l, Z, LAM, BB, CT, CB, karg(21) + l * 384, gw, NGW, lane, wave); }
#if EXP_SSMA
        { FRESH_IDS; ssm_chunks<false>(lds, l, Z, LAM, BB, CT, CB, karg(21) + l * 384, gw, NGW, lane, wave); }
#endif
        GSYNC();
        { FRESH_IDS; ssm_carry(l, LAMT, CB, gtid); }
        GSYNC();
        { FRESH_IDS; ssm_chunks<true>(lds, l, Z, LAM, BB, CT, CB, karg(21) + l * 384, gw, NGW, lane, wave, !ctx_out); }
        __syncthreads();
#endif
#ifndef NO_ATTN
#if EXP_ATTN
        attn_phase(lds, ctx_out, Z, rope, karg(23) + l * 8, karg(24) + (size_t)l * 8 * 465, G, H);
        __syncthreads();
#endif
        attn_phase(lds, ctx_out, Z, rope, karg(23) + l * 8, karg(24) + (size_t)l * 8 * 465, G);
#endif
        GSYNC();
        const int Mm = ctx_out ? MALL : MLAT;
        { EpiGlu E{Z + ZU, YS}; GEMM_CALL(EpiGlu, Z + ZU, LDZ, slC + SC_GLU, Mm, 512, 384, E); }
        GSYNC();
        { EpiMerge E{Z + ZGATE, Z + ZM, 1}; GEMM_CALL(EpiMerge, YS, 512, slC + SC_PSSM, Mm, DM, 384, E); }
        { EpiMerge E{Z + ZGATE + 1024, Z + ZM, 0}; GEMM_CALL(EpiMerge, Z + ZGQ, LDZ, slC + SC_PGQA, Mm, DM, 512, E); }
        { EpiMerge E{Z + ZGATE + 2048, Z + ZM, 0}; GEMM_CALL(EpiMerge, Z + ZNQ, LDZ, slC + SC_PNA, Mm, DM, 512, E); }
        GSYNC();
        { EpiResid E{out, xc, out, xc, modl, 5, 1.0f}; GEMM_CALL(EpiResid, Z + ZM, LDZ, slC + SC_OUT, Mm, DM, DM, E); }
        GSYNC();
        FFN_CONV(l, 1);
        { FRESH_IDS; norm_phase(out, xc, gl + 2 * DM, modl, 6, 7, H, Mm, gw, NGW, lane); }
        GSYNC();
        { EpiSwiglu E{HID, DFF}; GEMM_CALL(EpiSwiglu, H, DM, slA, Mm, 2 * DFF, DM, E); }
        GSYNC();
        { EpiResid E{out, xc, out, xc, modl, 8, 0.5f}; GEMM_CALL(EpiResid, HID, DFF, slB, Mm, DM, DFF, E); }
        GSYNC();
        }
}

__global__ void __launch_bounds__(512, 2) fwd_megakernel(Args args) {
    extern __shared__ __attribute__((aligned(16))) unsigned char lds_raw[];
    LAS unsigned char* lds = (LAS unsigned char*)lds_raw;
    cg::grid_group grid = cg::this_grid();
    if (threadIdx.x < 16) ((LAS unsigned*)(lds + LDS_BYTES - 64))[threadIdx.x] = 0u;
    __syncthreads();
    XcdBarrier xbar = xcd_barrier_post((unsigned*)((unsigned char*)karg(31) + WS_BAR), (volatile LAS unsigned*)(lds + LDS_BYTES - 64));
    const int G = gridDim.x, NGW = G * 8, gthreads = G * 512;
    unsigned char* ws = (unsigned char*)karg(31);
    float* mod = (float*)(ws + WS_MOD); float2* rope = (float2*)(ws + WS_ROPE); float2* LAM = (float2*)(ws + WS_LAM); float2* LAMT = (float2*)(ws + WS_LAMT);
    float2* BB = (float2*)(ws + WS_BB); bf16_t* CT = (bf16_t*)(ws + WS_CT); float2* CB = (float2*)(ws + WS_CB); float* xc = (float*)(ws + WS_XC);
    bf16_t* slA = (bf16_t*)(ws + WS_SLA); bf16_t* slB = (bf16_t*)(ws + WS_SLB); bf16_t* slC = (bf16_t*)(ws + WS_SLC);
    bf16_t* H = (bf16_t*)(ws + WS_H); bf16_t* Z = (bf16_t*)(ws + WS_Z); bf16_t* HID = Z; bf16_t* YS = H;
    const float* x = karg(0); const float* ctx = karg(2); float* out = (float*)karg(30);
    const float* norm_g = karg(6);
    mod_gemv(lds, karg(1), karg(3), karg(4), karg(5), mod, G);
    { FRESH_IDS; make_tables(karg(14), karg(15), karg(16), karg(17), karg(18), karg(19), karg(20), rope, LAM, LAMT, BB, CT, gtid, gthreads); }
    __syncthreads();
    FFN_CONV(0, 0);
    grid.sync();

    layer_body<0>(args, lds, xbar, G, NGW, gthreads);
    layer_body<1>(args, lds, xbar, G, NGW, gthreads);
    { FRESH_IDS; final_norm(out, karg(29), gw, NGW, lane); }
}

extern "C" void kernel_launch(void* const* d_in, const int* in_sizes, int n_in, void* d_out, int out_size, void* d_ws, size_t ws_size, hipStream_t stream) {
    static int grid = 0;
    if (grid == 0) {
        if (n_in != 30 || out_size != MLAT * DM || ws_size < WS_END) { fprintf(stderr, "kernel_launch: unexpected problem (n_in %d, out %d, ws %zu < %zu)\n", n_in, out_size, ws_size, (size_t)WS_END); grid = -1; return; }
        int dev = 0, cus = 0, per_cu = 0;
        hipGetDevice(&dev); hipDeviceGetAttribute(&cus, hipDeviceAttributeMultiprocessorCount, dev);
        hipFuncSetAttribute((const void*)fwd_megakernel, hipFuncAttributeMaxDynamicSharedMemorySize, LDS_BYTES);
        hipOccupancyMaxActiveBlocksPerMultiprocessor(&per_cu, (const void*)fwd_megakernel, 512, LDS_BYTES);
        if (per_cu < 1) { fprintf(stderr, "kernel_launch: occupancy query says %d blocks/CU\n", per_cu); per_cu = 1; }
        grid = cus * per_cu;
        (void)hipGetLastError();
    }
    if (grid < 0) return;
    Args a{};
    for (int i = 0; i < 30; ++i) a.in[i] = (const float*)d_in[i];
    a.out = (float*)d_out; a.ws = (unsigned char*)d_ws;
    if (hipMemsetAsync((unsigned char*)d_ws + WS_BAR, 0, 16384, stream) != hipSuccess) { fprintf(stderr, "kernel_launch: memset failed\n"); return; }
    void* kargs[] = {&a};
    hipError_t e = hipLaunchCooperativeKernel((const void*)fwd_megakernel, dim3(grid), dim3(512), kargs, LDS_BYTES, stream);
    if (e != hipSuccess) fprintf(stderr, "cooperative launch failed: %s (grid %d)\n", hipGetErrorString(e), grid);
}
```

```cpp
#include <hip/hip_runtime.h>
#include <hip/hip_cooperative_groups.h>
#include <cstdio>
#include <cstdint>
namespace cg = cooperative_groups;
namespace pg8 {
#define PG8_LAS __attribute__((address_space(3)))
typedef unsigned short bf16_t;
typedef short bf16x8 __attribute__((ext_vector_type(8)));
typedef float f32x4 __attribute__((ext_vector_type(4)));
typedef unsigned u32x4 __attribute__((ext_vector_type(4)));
constexpr int BM = 256, BK = 64, HALF = 128, HTB = HALF * BK * 2  , STAGE_BYTES = 8 * HTB, NXCD = 8, WGM = 4;

__host__ __device__ __forceinline__ int lds_byte(int r, int c) { const int st = (r >> 4) * 2 + (c >> 5), rr = r & 15, cc = c & 31, ob = rr * 64 + cc * 2; return st * 1024 + (ob ^ (((ob >> 9) & 1) << 5)); }
__host__ __device__ __forceinline__ void stage_rc(int b, int& R, int& C) { const int st = b / 1024, sb = b % 1024, swz = sb ^ (((sb >> 9) & 1) << 5); R = (st >> 1) * 16 + swz / 64; C = (st & 1) * 32 + (swz % 64) / 2; }
__host__ __device__ __forceinline__ int perm32(int rho) { const int n = rho >> 4, i = rho & 15; return 8 * (i >> 2) + 4 * n + (i & 3); }

struct Unit { int pm, pn; };
struct Gemm { const bf16_t* A; const bf16_t* Bt; int M, N, K, lda, ldb; };

struct StaticOrder {
    int nM, nN, nwg, G, c;
    __host__ __device__ void init(int M, int N, int G_, int c_) { nM = M / BM; nN = N / BM; nwg = nM * nN; G = G_; c = c_; }
    __host__ __device__ bool next(int i, Unit& u) const {
        const long L = (long)i * G + c; if (L >= nwg) return false;
        int wgid = (int)L; { const int q = nwg / NXCD, r = nwg % NXCD, xcd = wgid % NXCD, off = wgid / NXCD; wgid = (xcd < r ? xcd * (q + 1) : r * (q + 1) + (xcd - r) * q) + off; }
        const int nig = WGM * nN, gid = wgid / nig, fm = gid * WGM, gsz = (nM - fm) < WGM ? (nM - fm) : WGM;
        u.pm = fm + ((wgid % nig) % gsz); u.pn = (wgid % nig) / gsz; return true;
    }
    __device__ __forceinline__ void a_ready(const Unit&) const {}
    __device__ __forceinline__ void done(const Unit&) const {}
};

struct G3L1Order {
    StaticOrder S1; int G, c;
    __host__ __device__ void init(int Mlat, int N, int G_, int c_) { S1.init(Mlat, N, G_, c_); G = G_; c = c_; }
    __host__ __device__ bool next(int i, Unit& u) const {
        if (S1.next(i, u)) return true;
        const long L = (long)i * G + c - S1.nwg; if (L < 0 || L >= 72) return false;
        const int t = (int)L, pt = t % 9; u.pm = 128 + t / 9; u.pn = pt < 2 ? pt : (pt < 4 ? pt + 1 : pt + 2); return true;
    }
    __device__ __forceinline__ void a_ready(const Unit&) const {}
    __device__ __forceinline__ void done(const Unit&) const {}
};
__device__ __forceinline__ unsigned cvt_pk_bf16(float lo, float hi) { unsigned r; asm volatile("v_cvt_pk_bf16_f32 %0, %1, %2" : "=v"(r) : "v"(lo), "v"(hi)); return r; }
template <class Epi, class Sched, bool ALIGN_EPI = false, bool SP2 = false>
__device__ __forceinline__ void gemm_phase(PG8_LAS unsigned char* lds, const Gemm g, const Sched& S, const Epi& E) {
    int tid = threadIdx.x; asm volatile("" : "+v"(tid));
    const int wid = __builtin_amdgcn_readfirstlane(tid >> 6), lane = tid & 63, wr = wid >> 2, wc = wid & 3, fr = lane & 15, fq = lane >> 4;
    const int K = g.K, nt = K / BK;
    unsigned voffA[2], voffB[2];
#pragma unroll
    for (int i = 0; i < 2; ++i) { int R, C; stage_rc(tid * 16 + i * 8192, R, C); const int Rb = Epi::PERM ? ((R & ~31) + perm32(R & 31)) : R;
        voffA[i] = (unsigned)(R * g.lda + C) * 2u; voffB[i] = (unsigned)(Rb * g.ldb + C) * 2u; }
    const size_t kstep = (size_t)(BK * 2);
    const size_t hstepA = (size_t)HALF * g.lda * 2, hstepB = (size_t)HALF * g.ldb * 2;
    const size_t tstepA = 2 * hstepA, tstepB = 2 * hstepB;
    const unsigned ldsw = (unsigned)wid * 1024u;
    const int aoff = lds_byte(wr * 64 + fr, fq * 8), boff = lds_byte(wc * 32 + fr, fq * 8);
#define PG8_SA(b, h) (((b) * 2 + (h)) * HTB)
#define PG8_SB(b, h) ((4 + (b) * 2 + (h)) * HTB)
#define PG8_STAGE(bufoff, gbase, voff) do { _Pragma("unroll") for (int _i = 0; _i < 2; ++_i) \
        __builtin_amdgcn_global_load_lds((const unsigned*)((const char*)(gbase) + (voff)[_i]), (PG8_LAS unsigned*)(lds + (bufoff) + ldsw + _i * 8192), 16, 0, 0); } while (0)
#define PG8_LDA(dst, b, h) do { _Pragma("unroll") for (int m = 0; m < 4; ++m) _Pragma("unroll") for (int k = 0; k < 2; ++k) dst[m][k] = *(const PG8_LAS bf16x8*)(lds + PG8_SA(b, h) + aoff + m * 2048 + k * 1024); } while (0)
#define PG8_LDB(dst, b, h) do { _Pragma("unroll") for (int n = 0; n < 2; ++n) _Pragma("unroll") for (int k = 0; k < 2; ++k) dst[n][k] = *(const PG8_LAS bf16x8*)(lds + PG8_SB(b, h) + boff + n * 2048 + k * 1024); } while (0)
#define PG8_MMA(ai, bj, At, Bt) do { __builtin_amdgcn_s_setprio(1); _Pragma("unroll") for (int m = 0; m < 4; ++m) _Pragma("unroll") for (int n = 0; n < 2; ++n) _Pragma("unroll") for (int k = 0; k < 2; ++k) \
        acc[ai][bj][m][n] = __builtin_amdgcn_mfma_f32_16x16x32_bf16(Bt[n][k], At[m][k], acc[ai][bj][m][n], 0, 0, 0); __builtin_amdgcn_s_setprio(0); } while (0)
#define PG8_WAIT_V(n) asm volatile("s_waitcnt vmcnt(" #n ")" ::: "memory")
#define PG8_WAIT_L(n) asm volatile("s_waitcnt lgkmcnt(" #n ")" ::: "memory")
#define PG8_BAR __builtin_amdgcn_s_barrier()
#define PG8_SCHED __builtin_amdgcn_sched_barrier(0)
    Unit cur, nxt; int ui = 0;
    if (!S.next(0, cur)) return;
    f32x4 acc[2][2][4][2];
#pragma unroll
    for (int a = 0; a < 2; ++a)
#pragma unroll
        for (int b = 0; b < 2; ++b)
#pragma unroll
            for (int m = 0; m < 4; ++m)
#pragma unroll
                for (int n = 0; n < 2; ++n) acc[a][b][m][n] = (f32x4){0.f, 0.f, 0.f, 0.f};
    bf16x8 At[4][2], B0[2][2], B1[2][2];
    const char* cA = (const char*)g.A + (size_t)cur.pm * tstepA; const char* cB = (const char*)g.Bt + (size_t)cur.pn * tstepB;
    S.a_ready(cur);
    if constexpr (SP2) {
        PG8_STAGE(PG8_SB(0, 0), cB, voffB); PG8_STAGE(PG8_SB(0, 1), cB + hstepB, voffB); PG8_STAGE(PG8_SA(0, 0), cA, voffA); PG8_STAGE(PG8_SA(0, 1), cA + hstepA, voffA);
        if (wr == 1) PG8_BAR;
        PG8_WAIT_V(2); PG8_BAR;
        PG8_STAGE(PG8_SB(1, 0), cB + kstep, voffB); PG8_STAGE(PG8_SA(1, 0), cA + kstep, voffA); PG8_STAGE(PG8_SB(1, 1), cB + hstepB + kstep, voffB);
        PG8_WAIT_V(6); PG8_BAR;
    } else {
        PG8_STAGE(PG8_SB(0, 0), cB, voffB); PG8_STAGE(PG8_SA(0, 0), cA, voffA); PG8_STAGE(PG8_SB(0, 1), cB + hstepB, voffB); PG8_STAGE(PG8_SA(0, 1), cA + hstepA, voffA);
        if (wr == 1) PG8_BAR;
        PG8_WAIT_V(4); PG8_BAR;
        PG8_STAGE(PG8_SB(1, 0), cB + kstep, voffB); PG8_STAGE(PG8_SA(1, 0), cA + kstep, voffA); PG8_STAGE(PG8_SB(1, 1), cB + hstepB + kstep, voffB);
        PG8_WAIT_V(6); PG8_BAR;
    }
    for (;;) {
        const bool has_next = S.next(ui + 1, nxt);
        const char* nA = has_next ? (const char*)g.A + (size_t)nxt.pm * tstepA : cA; const char* nB = has_next ? (const char*)g.Bt + (size_t)nxt.pn * tstepB : cB;
        for (int t = 0; t < nt; t += 2) {
            const bool last = (t == nt - 2);
            const char* a1 = cA + (size_t)(t + 1) * kstep;
            const char* a2 = last ? nA : cA + (size_t)(t + 2) * kstep; const char* b2 = last ? nB : cB + (size_t)(t + 2) * kstep;
            const char* a3 = a2 + kstep; const char* b3 = b2 + kstep;
            if (last && has_next) S.a_ready(nxt);
            if constexpr (SP2) {
            PG8_LDB(B0, 0, 0); PG8_LDB(B1, 0, 1); PG8_SCHED; PG8_LDA(At, 0, 0); PG8_STAGE(PG8_SA(1, 1), a1 + hstepA, voffA);
            PG8_WAIT_V(8); PG8_WAIT_L(0); PG8_BAR; PG8_MMA(0, 0, At, B0); PG8_MMA(0, 1, At, B1); PG8_BAR; PG8_SCHED;
            PG8_LDA(At, 0, 1); PG8_STAGE(PG8_SB(0, 0), b2, voffB); PG8_STAGE(PG8_SB(0, 1), b2 + hstepB, voffB); PG8_STAGE(PG8_SA(0, 0), a2, voffA);
            PG8_WAIT_V(8); PG8_WAIT_L(0); PG8_BAR; PG8_MMA(1, 0, At, B0); PG8_MMA(1, 1, At, B1); PG8_BAR; PG8_SCHED;
            PG8_LDB(B0, 1, 0); PG8_LDB(B1, 1, 1); PG8_SCHED; PG8_LDA(At, 1, 0); PG8_STAGE(PG8_SA(0, 1), a2 + hstepA, voffA);
            PG8_WAIT_V(8); PG8_WAIT_L(0); PG8_BAR; PG8_MMA(0, 0, At, B0); PG8_MMA(0, 1, At, B1); PG8_BAR; PG8_SCHED;
            PG8_LDA(At, 1, 1); PG8_STAGE(PG8_SB(1, 0), b3, voffB); PG8_STAGE(PG8_SB(1, 1), b3 + hstepB, voffB); PG8_STAGE(PG8_SA(1, 0), a3, voffA);
            PG8_WAIT_V(8); PG8_WAIT_L(0); PG8_BAR; PG8_MMA(1, 0, At, B0); PG8_MMA(1, 1, At, B1); PG8_BAR; PG8_SCHED;
            } else {
            PG8_LDB(B0, 0, 0); PG8_SCHED; PG8_LDA(At, 0, 0); PG8_STAGE(PG8_SA(1, 1), a1 + hstepA, voffA);
            PG8_WAIT_L(8); PG8_BAR; PG8_WAIT_L(0); PG8_MMA(0, 0, At, B0); PG8_BAR; PG8_SCHED;
            PG8_LDB(B1, 0, 1); PG8_STAGE(PG8_SB(0, 0), b2, voffB);
            PG8_BAR; PG8_WAIT_L(0); PG8_MMA(0, 1, At, B1); PG8_BAR;
            PG8_LDA(At, 0, 1); PG8_STAGE(PG8_SA(0, 0), a2, voffA);
            PG8_BAR; PG8_WAIT_L(0); PG8_MMA(1, 0, At, B0); PG8_BAR; PG8_SCHED;
            PG8_STAGE(PG8_SB(0, 1), b2 + hstepB, voffB);
            PG8_WAIT_V(6); PG8_BAR; PG8_MMA(1, 1, At, B1); PG8_BAR;
            PG8_LDB(B0, 1, 0); PG8_SCHED; PG8_LDA(At, 1, 0); PG8_STAGE(PG8_SA(0, 1), a2 + hstepA, voffA);
            PG8_WAIT_L(8); PG8_BAR; PG8_WAIT_L(0); PG8_MMA(0, 0, At, B0); PG8_BAR; PG8_SCHED;
            PG8_LDB(B1, 1, 1); PG8_STAGE(PG8_SB(1, 0), b3, voffB);
            PG8_BAR; PG8_WAIT_L(0); PG8_MMA(0, 1, At, B1); PG8_BAR;
            PG8_LDA(At, 1, 1); PG8_STAGE(PG8_SA(1, 0), a3, voffA);
            PG8_BAR; PG8_WAIT_L(0); PG8_MMA(1, 0, At, B0); PG8_BAR; PG8_SCHED;
            PG8_STAGE(PG8_SB(1, 1), b3 + hstepB, voffB);
            PG8_WAIT_V(6); PG8_BAR; PG8_MMA(1, 1, At, B1); PG8_BAR;
            }
        }
        if constexpr (ALIGN_EPI) { if (wr == 0) PG8_BAR; }
        if constexpr (!Epi::AFTER_DRAIN) { E(acc, cur, wr, wc, fr, fq); S.done(cur); }
        if (!has_next) break;
#pragma unroll
        for (int a = 0; a < 2; ++a)
#pragma unroll
            for (int b = 0; b < 2; ++b)
#pragma unroll
                for (int m = 0; m < 4; ++m)
#pragma unroll
                    for (int n = 0; n < 2; ++n) acc[a][b][m][n] = (f32x4){0.f, 0.f, 0.f, 0.f};
        cur = nxt; cA = nA; cB = nB; ++ui;
        if constexpr (ALIGN_EPI) { if (wr == 1) PG8_BAR; }
    }
    PG8_WAIT_V(0);
    if constexpr (!ALIGN_EPI) { if (wr == 0) PG8_BAR; }
    PG8_BAR;
    if constexpr (Epi::AFTER_DRAIN) { E.fused(acc, cur, wr, wc, fr, fq, lds, wid, lane); S.done(cur); }
#undef PG8_SA
#undef PG8_SB
#undef PG8_STAGE
#undef PG8_LDA
#undef PG8_LDB
#undef PG8_MMA
#undef PG8_WAIT_V
#undef PG8_WAIT_L
#undef PG8_BAR
#undef PG8_SCHED
}
}

#ifndef EXP_G1
#define EXP_G1 0
#endif
#ifndef EXP_SSMA
#define EXP_SSMA 0
#endif
#ifndef EXP_ATTN
#define EXP_ATTN 0
#endif
#ifndef EXP_NORM
#define EXP_NORM 0
#endif
#ifndef EXP_SYNC
#define EXP_SYNC 0
#endif
using pg8::bf16_t; using pg8::bf16x8; using pg8::f32x4; using pg8::u32x4;
#define LAS __attribute__((address_space(3)))
typedef unsigned u32x2 __attribute__((ext_vector_type(2)));
typedef float f32x2 __attribute__((ext_vector_type(2)));
constexpr int DM = 1024, NBATCH = 8, SEQ = 4096, CTXL = 256, DFF = 2816, NIN = 5760, LDZ = 5888;
constexpr int MLAT = NBATCH * SEQ, MCTX = NBATCH * CTXL, MALL = MLAT + MCTX;
constexpr int ZU = 0, ZGQ = 384, ZGK = 896, ZGV = 1024, ZNQ = 1152, ZNK = 1664, ZNV = 2176, ZGATE = 2688, ZM = 1664;
constexpr int NGRP = 24, NCH = 68;
constexpr float LOG2E = 1.4426950408889634f;
constexpr int LDS_BYTES = 147456;
constexpr size_t MiB = 1u << 20;
constexpr size_t WS_MOD = 0, WS_ROPE = 1 * MiB, WS_LAM = WS_ROPE + 65536, WS_LAMT = WS_LAM + 65536, WS_BB = 2 * MiB, WS_CT = 3 * MiB;
constexpr size_t WS_CB = 4 * MiB, WS_XC = 18 * MiB, WS_SLA = 26 * MiB, WS_SLB = 38 * MiB, WS_SLC = 44 * MiB, WS_H = 50 * MiB, WS_Z = 118 * MiB, WS_END = 509 * MiB;
static_assert(WS_Z + (size_t)MALL * LDZ * 2 <= WS_END, "ws map");
constexpr size_t SC_GLU = 0, SC_PSSM = 512 * 384, SC_PGQA = SC_PSSM + 1024 * 384, SC_PNA = SC_PGQA + 1024 * 512, SC_OUT = SC_PNA + 1024 * 512;

__device__ __forceinline__ unsigned f2bf(float f) { unsigned u = __builtin_bit_cast(unsigned, f); return (u + 0x7fffu + ((u >> 16) & 1u)) >> 16; }
__device__ __forceinline__ unsigned pk2(float lo, float hi) { unsigned r; asm("v_cvt_pk_bf16_f32 %0, %1, %2" : "=v"(r) : "v"(lo), "v"(hi)); return r; }
__device__ __forceinline__ float bflo(unsigned w) { return __builtin_bit_cast(float, w << 16); }
__device__ __forceinline__ float bfhi(unsigned w) { return __builtin_bit_cast(float, w & 0xffff0000u); }
__device__ __forceinline__ float sigmoidf_(float x) { return __builtin_amdgcn_rcpf(1.f + __expf(-x)); }
__device__ __forceinline__ float siluf_(float x) { return x * sigmoidf_(x); }
__device__ __forceinline__ float gelu_tanh(float x) { return x * sigmoidf_(1.5957691216057308f * (x + 0.044715f * x * x * x)); }

struct EpiSwiglu {
    static constexpr bool PERM = true, AFTER_DRAIN = false;
    bf16_t* O; int ldo;
    __device__ __forceinline__ void operator()(const f32x4 (&acc)[2][2][4][2], const pg8::Unit& u, int wr, int wc, int fr, int fq) const {
        const int row0 = u.pm * 256 + wr * 64 + fr, col0 = u.pn * 128 + wc * 32 + 8 * fq;
#pragma unroll
        for (int ai = 0; ai < 2; ++ai)
#pragma unroll
            for (int m = 0; m < 4; ++m) {
                bf16_t* rowp = O + (size_t)(row0 + ai * 128 + m * 16) * ldo + col0;
                const f32x4 g0 = acc[ai][0][m][0], g1 = acc[ai][0][m][1], u0 = acc[ai][1][m][0], u1 = acc[ai][1][m][1];
                u32x4 w;
                w.x = pk2(siluf_(g0[0]) * u0[0], siluf_(g0[1]) * u0[1]); w.y = pk2(siluf_(g0[2]) * u0[2], siluf_(g0[3]) * u0[3]);
                w.z = pk2(siluf_(g1[0]) * u1[0], siluf_(g1[1]) * u1[1]); w.w = pk2(siluf_(g1[2]) * u1[2], siluf_(g1[3]) * u1[3]);
                *(u32x4*)rowp = w;
            }
    }
};
struct EpiStore {
    static constexpr bool PERM = true, AFTER_DRAIN = false;
    bf16_t* O; int ldo;
    __device__ __forceinline__ void operator()(const f32x4 (&acc)[2][2][4][2], const pg8::Unit& u, int wr, int wc, int fr, int fq) const {
        const int row0 = u.pm * 256 + wr * 64 + fr, col0 = u.pn * 256 + wc * 32 + 8 * fq;
#pragma unroll
        for (int ai = 0; ai < 2; ++ai)
#pragma unroll
            for (int m = 0; m < 4; ++m)
#pragma unroll
                for (int bj = 0; bj < 2; ++bj) {
                    const f32x4 v0 = acc[ai][bj][m][0], v1 = acc[ai][bj][m][1];
                    u32x4 w; w.x = pk2(v0[0], v0[1]); w.y = pk2(v0[2], v0[3]); w.z = pk2(v1[0], v1[1]); w.w = pk2(v1[2], v1[3]);
                    *(u32x4*)(O + (size_t)(row0 + ai * 128 + m * 16) * ldo + col0 + bj * 128) = w;
                }
    }
};
struct EpiGlu {
    static constexpr bool PERM = true, AFTER_DRAIN = false;
    const bf16_t* T; bf16_t* YS;
    __device__ __forceinline__ void operator()(const f32x4 (&acc)[2][2][4][2], const pg8::Unit& u, int wr, int wc, int fr, int fq) const {
        const int row0 = u.pm * 256 + wr * 64 + fr, col0 = u.pn * 256 + wc * 32 + 8 * fq;
#pragma unroll
        for (int ai = 0; ai < 2; ++ai)
#pragma unroll
            for (int m = 0; m < 4; ++m)
#pragma unroll
                for (int bj = 0; bj < 2; ++bj) {
                    const size_t row = (size_t)(row0 + ai * 128 + m * 16); const int col = col0 + bj * 128;
                    const u32x4 t = *(const u32x4*)(T + row * LDZ + col);
                    const f32x4 v0 = acc[ai][bj][m][0], v1 = acc[ai][bj][m][1];
                    u32x4 w;
                    w.x = pk2(bflo(t.x) * sigmoidf_(v0[0]), bfhi(t.x) * sigmoidf_(v0[1])); w.y = pk2(bflo(t.y) * sigmoidf_(v0[2]), bfhi(t.y) * sigmoidf_(v0[3]));
                    w.z = pk2(bflo(t.z) * sigmoidf_(v1[0]), bfhi(t.z) * sigmoidf_(v1[1])); w.w = pk2(bflo(t.w) * sigmoidf_(v1[2]), bfhi(t.w) * sigmoidf_(v1[3]));
                    *(u32x4*)(YS + row * 512 + col) = w;
                    asm volatile("" ::: "memory");
                }
    }
};
struct EpiMerge {
    static constexpr bool PERM = true, AFTER_DRAIN = false;
    const bf16_t* Gt; bf16_t* Mo; int first;
    __device__ __forceinline__ void operator()(const f32x4 (&acc)[2][2][4][2], const pg8::Unit& u, int wr, int wc, int fr, int fq) const {
        const int row0 = u.pm * 256 + wr * 64 + fr, col0 = u.pn * 256 + wc * 32 + 8 * fq;
#pragma unroll
        for (int ai = 0; ai < 2; ++ai)
#pragma unroll
            for (int m = 0; m < 4; ++m)
#pragma unroll
                for (int bj = 0; bj < 2; ++bj) {
                    const size_t off = (size_t)(row0 + ai * 128 + m * 16) * LDZ + col0 + bj * 128;
                    const u32x4 gt = *(const u32x4*)(Gt + off);
                    const f32x4 v0 = acc[ai][bj][m][0], v1 = acc[ai][bj][m][1];
                    float o[8] = {sigmoidf_(bflo(gt.x)) * v0[0], sigmoidf_(bfhi(gt.x)) * v0[1], sigmoidf_(bflo(gt.y)) * v0[2], sigmoidf_(bfhi(gt.y)) * v0[3],
                                  sigmoidf_(bflo(gt.z)) * v1[0], sigmoidf_(bfhi(gt.z)) * v1[1], sigmoidf_(bflo(gt.w)) * v1[2], sigmoidf_(bfhi(gt.w)) * v1[3]};
                    if (!first) { const u32x4 p = *(const u32x4*)(Mo + off);
                        o[0] += bflo(p.x); o[1] += bfhi(p.x); o[2] += bflo(p.y); o[3] += bfhi(p.y); o[4] += bflo(p.z); o[5] += bfhi(p.z); o[6] += bflo(p.w); o[7] += bfhi(p.w); }
                    u32x4 w; w.x = pk2(o[0], o[1]); w.y = pk2(o[2], o[3]); w.z = pk2(o[4], o[5]); w.w = pk2(o[6], o[7]);
                    *(u32x4*)(Mo + off) = w;
                    asm volatile("" ::: "memory");
                }
    }
};
struct EpiResid {
    static constexpr bool PERM = false, AFTER_DRAIN = false;
    const float* baseL; const float* baseC; float* outL; float* outC; const float* mod; int midx; float coef;
    __device__ __forceinline__ void operator()(const f32x4 (&acc)[2][2][4][2], const pg8::Unit& u, int wr, int wc, int fr, int fq) const {
        const bool lat = u.pm < 128;
        const float* base = lat ? baseL + (size_t)u.pm * 256 * DM : baseC + (size_t)(u.pm - 128) * 256 * DM;
        float* out = lat ? outL + (size_t)u.pm * 256 * DM : outC + (size_t)(u.pm - 128) * 256 * DM;
        const int j = lat ? (u.pm >> 4) : 8;
        const float* mv = mod + (size_t)j * 9216 + midx * 1024;
        const int row0 = wr * 64 + fr, col0 = u.pn * 256 + wc * 32 + 4 * fq;
#pragma unroll
        for (int bj = 0; bj < 2; ++bj)
#pragma unroll
            for (int n = 0; n < 2; ++n) {
                const int col = col0 + bj * 128 + n * 16;
                const f32x4 mm = *(const f32x4*)(mv + col) * coef;
#pragma unroll
                for (int ai = 0; ai < 2; ++ai)
#pragma unroll
                    for (int m = 0; m < 4; ++m) {
                        const size_t off = (size_t)(row0 + ai * 128 + m * 16) * DM + col;
                        const f32x4 bs = *(const f32x4*)(base + off);
                        *(f32x4*)(out + off) = bs + mm * acc[ai][bj][m][n];
                        if (m & 1) asm volatile("" ::: "memory");
                    }
            }
    }
};

__device__ __forceinline__ float wave_sum(float v) {
#pragma unroll
    for (int o = 1; o < 64; o <<= 1) v += __shfl_xor(v, o);
    return v;
}
__device__ __forceinline__ void conv_job(LAS unsigned char* lds, const float* W, int K, int N, bf16_t* WT, int kind, int gw, int NGW, int lane, int wave) {
    LAS float* scr = (LAS float*)(lds + wave * 9216);
    const int nblk = N / 32, nitems = (K / 64) * nblk;
    for (int item = gw; item < nitems; item += NGW) {
        const int kb = item / nblk, nb = item % nblk, k0 = 64 * kb, n0 = 32 * nb;
        const int d0 = kind == 0 ? n0 : ((n0 >> 7) * 256 + (n0 & 127) + (kind == 2 ? 128 : 0));
#pragma unroll 8
        for (int i = 0; i < 32; ++i) { const int kk = 2 * i + (lane >> 5); scr[kk * 33 + (lane & 31)] = W[(size_t)(k0 + kk) * N + n0 + (lane & 31)]; }
        asm volatile("s_waitcnt lgkmcnt(0)" ::: "memory");
        const int c = lane & 7;
#pragma unroll
        for (int j = 0; j < 4; ++j) { const int n = (lane >> 3) + 8 * j; const LAS float* s = scr + (8 * c) * 33 + n;
            u32x4 o; o.x = pk2(s[0 * 33], s[1 * 33]); o.y = pk2(s[2 * 33], s[3 * 33]); o.z = pk2(s[4 * 33], s[5 * 33]); o.w = pk2(s[6 * 33], s[7 * 33]);
            *(u32x4*)(WT + (size_t)(d0 + n) * K + k0 + 8 * c) = o; }
        asm volatile("s_waitcnt lgkmcnt(0)" ::: "memory");
    }
}
__device__ __forceinline__ void zero_rows(bf16_t* p, size_t n16  , int gtid, int gthreads) {
    for (size_t i = gtid; i < n16; i += gthreads) ((u32x4*)p)[i] = (u32x4){0u, 0u, 0u, 0u};
}
__device__ __forceinline__ void mod_gemv(LAS unsigned char* lds, const float* c, const float* cctx, const float* w_ada, const float* b_ada, float* mod, int G) {
    LAS float* sv = (LAS float*)lds;
    LAS float* part = (LAS float*)(lds + 40960);
    int tid = threadIdx.x; asm volatile("" : "+v"(tid));
    for (int i = tid; i < 9 * 1024; i += 512) { const float v = (i < 8192) ? c[i] : cctx[i - 8192]; sv[i] = v / (1.f + expf(-v)); }
    __syncthreads();
    const int col = tid & 31, kseg = tid >> 5;
    for (int item = blockIdx.x; item < 576; item += G) {
        const int l = item / 288, n0 = (item % 288) * 32;
        const float* w = w_ada + (size_t)l * 1024 * 9216 + n0 + col;
        float acc[9];
#pragma unroll
        for (int j = 0; j < 9; ++j) acc[j] = 0.f;
#pragma unroll 4
        for (int kk = 0; kk < 64; ++kk) { const int k = kseg * 64 + kk; const float wv = w[(size_t)k * 9216];
#pragma unroll
            for (int j = 0; j < 9; ++j) acc[j] += sv[j * 1024 + k] * wv; }
#pragma unroll
        for (int j = 0; j < 9; ++j) part[(kseg * 9 + j) * 32 + col] = acc[j];
        __syncthreads();
        if (tid < 288) { const int j = tid >> 5; float s = 0.f;
#pragma unroll
            for (int ks = 0; ks < 16; ++ks) s += part[(ks * 9 + j) * 32 + col];
            mod[((size_t)l * 9 + j) * 9216 + n0 + col] = s + b_ada[l * 9216 + n0 + col]; }
        __syncthreads();
    }
}
__device__ __forceinline__ void make_tables(const float* a_re, const float* a_im, const float* log_dt, const float* b_re, const float* b_im, const float* c_re, const float* c_im,
                                            float2* rope, float2* LAM, float2* LAMT, float2* BB, bf16_t* CT, int gtid, int gthreads) {
    for (int i = gtid; i < 1024; i += gthreads) { const int pos = i >> 4, j = i & 15; const float inv = powf(10000.f, -(float)j / 16.f); const float ang = (float)pos * inv; rope[i] = make_float2(cosf(ang), sinf(ang)); }
    for (int i = gtid; i < 2 * 2 * NGRP * 64; i += gthreads) {
        const float are = a_re[i], aim = a_im[i], dt = expf(log_dt[i >> 6]);
        const float mg = expf(are * dt), lbr = mg * cosf(aim * dt), lbi = mg * sinf(aim * dt);
        const float d2 = are * are + aim * aim, nr = lbr - 1.f, ni = lbi;
        const float cr = (nr * are + ni * aim) / d2, ci = (ni * are - nr * aim) / d2;
        LAM[i] = make_float2(lbr, lbi);
        float pr = lbr, pi = lbi;
#pragma unroll
        for (int s = 0; s < 6; ++s) { const float t = pr * pr - pi * pi; pi = 2.f * pr * pi; pr = t; }
        LAMT[i] = make_float2(pr, pi);
        for (int k = 0; k < 16; ++k) { const float br = b_re[(size_t)i * 16 + k], bi = b_im[(size_t)i * 16 + k]; BB[(size_t)i * 16 + k] = make_float2(cr * br - ci * bi, cr * bi + ci * br); }
    }
    for (int i = gtid; i < 2 * 2 * NGRP * 4 * 64 * 8; i += gthreads) {
        const int e = i & 7, lane = (i >> 3) & 63, ks = (i >> 9) & 3, rest = i >> 11;
        const int n = lane & 15, g4 = lane >> 4, k = 32 * ks + 8 * g4 + e, p = k >> 1;
        const size_t ci = ((size_t)rest * 16 + n) * 64 + p;
        CT[i] = (bf16_t)f2bf((k & 1) ? -c_im[ci] : c_re[ci]);
    }
}
__device__ __forceinline__ void norm_phase(const float* srcL, const float* srcC, const float* g, const float* mod, int ishift, int iscale, bf16_t* H, int nrows, int gw, int NGW, int lane) {
    for (int r = gw; r < nrows; r += NGW) {
        const float* xr = r < MLAT ? srcL + (size_t)r * DM : srcC + (size_t)(r - MLAT) * DM;
        const int j = r < MLAT ? (r >> 12) : 8;
        const float* sh = mod + (size_t)j * 9216 + ishift * 1024; const float* sc = mod + (size_t)j * 9216 + iscale * 1024;
        f32x4 v[4]; float s = 0.f;
#pragma unroll
        for (int q = 0; q < 4; ++q) { v[q] = ((const f32x4*)xr)[lane + 64 * q]; s += (v[q].x * v[q].x + v[q].y * v[q].y) + (v[q].z * v[q].z + v[q].w * v[q].w); }
        const float rstd = rsqrtf(wave_sum(s) * (1.f / DM) + 1e-6f);
#pragma unroll
        for (int q = 0; q < 4; ++q) {
            const f32x4 gg = ((const f32x4*)g)[lane + 64 * q], s1 = ((const f32x4*)sc)[lane + 64 * q], s0 = ((const f32x4*)sh)[lane + 64 * q];
            const f32x4 o = (v[q] * rstd * gg) * (s1 + 1.f) + s0;
            u32x2 w; w.x = pk2(o.x, o.y); w.y = pk2(o.z, o.w);
            ((u32x2*)(H + (size_t)r * DM))[lane + 64 * q] = w;
        }
    }
}
__device__ __forceinline__ void final_norm(float* out, const float* g, int gw, int NGW, int lane) {
    for (int r = gw; r < MLAT; r += NGW) {
        f32x4* xr = (f32x4*)(out + (size_t)r * DM);
        f32x4 v[4]; float s = 0.f;
#pragma unroll
        for (int q = 0; q < 4; ++q) { v[q] = xr[lane + 64 * q]; s += (v[q].x * v[q].x + v[q].y * v[q].y) + (v[q].z * v[q].z + v[q].w * v[q].w); }
        const float rstd = rsqrtf(wave_sum(s) * (1.f / DM) + 1e-6f);
#pragma unroll
        for (int q = 0; q < 4; ++q) xr[lane + 64 * q] = v[q] * rstd * ((const f32x4*)g)[lane + 64 * q];
    }
}

template <int MODE>
__device__ __forceinline__ void ssm_chunks(LAS unsigned char* lds, int l, bf16_t* z, float* YL, const float2* LAM, const float2* BB, const bf16_t* CT, float2* CB, const float* dvec, int gw, int NGW, int lane, int wave, bool skip_ctx = false) {
    LAS float* U = (LAS float*)(lds + wave * 9216);
    LAS unsigned char* Sb = lds + wave * 9216 + 4096;
    const int n = lane & 15, g4 = lane >> 4;
    for (int task = gw; task < NBATCH * NGRP * NCH; task += NGW) {
        const int grp = task % NGRP, tc = (task / NGRP) % NCH, b = task / (NCH * NGRP);
        const int row0 = tc < 4 ? MLAT + b * CTXL + tc * 64 : b * SEQ + (tc - 4) * 64;
        if (MODE == 1 && skip_ctx && tc < 4) continue;
        if (MODE == 0) {
            const bf16_t* up = z + (size_t)(row0 + lane) * LDZ + ZU + grp * 16;
            const u32x4 r0 = *(const u32x4*)up, r1 = *(const u32x4*)(up + 8);
            LAS f32x4* ud = (LAS f32x4*)(U + lane * 16);
            ud[0] = (f32x4){bflo(r0.x), bfhi(r0.x), bflo(r0.y), bfhi(r0.y)}; ud[1] = (f32x4){bflo(r0.z), bfhi(r0.z), bflo(r0.w), bfhi(r0.w)};
            ud[2] = (f32x4){bflo(r1.x), bfhi(r1.x), bflo(r1.y), bfhi(r1.y)}; ud[3] = (f32x4){bflo(r1.z), bfhi(r1.z), bflo(r1.w), bfhi(r1.w)};
        }
        f32x4 yacc[4];
#pragma unroll
        for (int q = 0; q < 4; ++q) yacc[q] = (f32x4){0.f, 0.f, 0.f, 0.f};
        for (int d = 0; d < 2; ++d) {
            const int sc = d == 0 ? tc : (tc < 4 ? 3 - tc : 71 - tc);
            const int pg = ((l * 2 + d) * NGRP + grp);
            const int pidx = pg * 64 + lane;
            const float2 lam = LAM[pidx];
            f32x4 bbv[8];
            if (MODE == 0) {
#pragma unroll
                for (int q = 0; q < 8; ++q) bbv[q] = ((const f32x4*)(BB + (size_t)pidx * 16))[q];
            }
            bf16x8 cf[4];
#pragma unroll
            for (int ks = 0; ks < 4; ++ks) cf[ks] = *(const bf16x8*)(CT + ((size_t)(pg * 4 + ks) * 64 + lane) * 8);
            const size_t cbi = ((((size_t)b * 2 + d) * NGRP + grp) * NCH + sc) * 64 + lane;
            float sr = 0.f, si = 0.f;
            if (MODE == 1) { const float2 c0 = CB[cbi]; sr = c0.x; si = c0.y; }
#pragma unroll
            for (int sub = 0; sub < 4; ++sub) {
                const int sb = d == 0 ? sub : 3 - sub;
#pragma unroll 4
                for (int tt = 0; tt < 16; ++tt) {
                    const int ti = d == 0 ? tt : 15 - tt;
                    float br = 0.f, bi = 0.f;
                    if (MODE == 0) {
                        const LAS f32x4* ur = (const LAS f32x4*)(U + (sb * 16 + ti) * 16);
#pragma unroll
                        for (int q = 0; q < 4; ++q) { const f32x4 uu = ur[q];
                            br += bbv[2 * q].x * uu.x; bi += bbv[2 * q].y * uu.x; br += bbv[2 * q].z * uu.y; bi += bbv[2 * q].w * uu.y;
                            br += bbv[2 * q + 1].x * uu.z; bi += bbv[2 * q + 1].y * uu.z; br += bbv[2 * q + 1].z * uu.w; bi += bbv[2 * q + 1].w * uu.w; }
                    }
                    const float nr = lam.x * sr - lam.y * si + br, ni = lam.x * si + lam.y * sr + bi;
                    sr = nr; si = ni;
                    *(LAS unsigned*)(Sb + ti * 272 + lane * 4) = pk2(sr, si);
                }
#pragma unroll
                for (int ks = 0; ks < 4; ++ks) {
                    const bf16x8 a = *(const LAS bf16x8*)(Sb + n * 272 + (32 * ks + 8 * g4) * 2);
                    if (sb == 0) yacc[0] = __builtin_amdgcn_mfma_f32_16x16x32_bf16(a, cf[ks], yacc[0], 0, 0, 0);
                    else if (sb == 1) yacc[1] = __builtin_amdgcn_mfma_f32_16x16x32_bf16(a, cf[ks], yacc[1], 0, 0, 0);
                    else if (sb == 2) yacc[2] = __builtin_amdgcn_mfma_f32_16x16x32_bf16(a, cf[ks], yacc[2], 0, 0, 0);
                    else yacc[3] = __builtin_amdgcn_mfma_f32_16x16x32_bf16(a, cf[ks], yacc[3], 0, 0, 0);
                }
            }
            if (MODE == 0) CB[cbi] = make_float2(sr, si);
        }
        if (MODE == 0) {
#pragma unroll
            for (int sb = 0; sb < 4; ++sb)
#pragma unroll
                for (int j = 0; j < 4; ++j) YL[(size_t)(row0 + sb * 16 + 4 * g4 + j) * 384 + grp * 16 + n] = yacc[sb][j];
        } else {
            const float dv = dvec[grp * 16 + n];
#pragma unroll
            for (int sb = 0; sb < 4; ++sb)
#pragma unroll
                for (int j = 0; j < 4; ++j) { const int tok = sb * 16 + 4 * g4 + j; bf16_t* zp = z + (size_t)(row0 + tok) * LDZ + ZU + grp * 16 + n;
                    const float uu = __builtin_bit_cast(float, (unsigned)(*zp) << 16);
                    const float y = yacc[sb][j] + YL[(size_t)(row0 + tok) * 384 + grp * 16 + n] + dv * uu;
                    *zp = (bf16_t)f2bf(gelu_tanh(y)); }
        }
        asm volatile("s_waitcnt lgkmcnt(0)" ::: "memory");
    }
}
__device__ __forceinline__ void ssm_carry(int l, const float2* LAMT, float2* CB, int gtid) {
    if (gtid < NBATCH * 2 * NGRP * 64) {
        const int p = gtid & 63, grp = (gtid >> 6) % NGRP, d = (gtid / (64 * NGRP)) & 1;
        const float2 lt = LAMT[((l * 2 + d) * NGRP + grp) * 64 + p];
        float2* base = CB + (size_t)(gtid >> 6) * NCH * 64 + p;
        float cr = 0.f, ci = 0.f;
#pragma unroll 4
        for (int sc = 0; sc < NCH; ++sc) { const float2 t = base[sc * 64]; base[sc * 64] = make_float2(cr, ci);
            const float nr = lt.x * cr - lt.y * ci + t.x, ni = lt.x * ci + lt.y * cr + t.y; cr = nr; ci = ni; }
    }
}

__device__ __forceinline__ void attn_phase(LAS unsigned char* lds, bool ctx_out, bf16_t* z, const float2* rope, const float* sink, const float* rpb, int G, bf16_t* dummy = nullptr) {
    int tid = threadIdx.x; asm volatile("" : "+v"(tid));
    const int lane = tid & 63, wave = tid >> 6, half = wave >> 2, wq = wave & 3, n = lane & 15, g4 = lane >> 4;
    LAS f32x2* ropeL = (LAS f32x2*)(lds + 73728);
    LAS float* rpbL = (LAS float*)(lds + 81920);
    for (int i = tid; i < 1024; i += 512) { const float2 rv = rope[i]; ropeL[i] = (f32x2){rv.x, rv.y}; }
    __syncthreads();
    const int nNA = 2048, nGQ = 2048, nCX = ctx_out ? 256 : 0, total = nNA + nGQ + nCX;
    const int tt = tid & 255, key = tt >> 2, cp = tt & 3;
    const int vkp = tt & 31, vch = 2 * (tt >> 6) + ((tt >> 5) & 1);
    for (int item = blockIdx.x; item < total; item += G) {
        int type, hi;
        if (item < nNA) { type = 1; hi = item * 2 + half; }
        else if (item < nNA + nGQ) { type = 0; hi = (item - nNA) * 2 + half; }
        else { const int r_ = item - nNA - nGQ; if (r_ < 128) { type = 2; hi = r_ * 2 + half; } else { type = 3; hi = (r_ - 128) * 2 + half; } }
        int b, h, qrow0, qcol, kcol, vcol, ntiles, q0 = 0, t_lo = 0, r = 0, rs = 0;
        float mrun = -1e30f, lsum = 0.f;
        if (type == 0) { const int kvh = hi & 1, qc = (hi >> 1) & 255; b = hi >> 9; h = kvh * 4 + wq; q0 = qc * 16; qrow0 = b * SEQ + q0; qcol = ZGQ + h * 64; kcol = ZGK + kvh * 64; vcol = ZGV + kvh * 64; ntiles = 10; t_lo = (q0 - 128) >> 6; mrun = sink[h] * LOG2E; lsum = g4 == 0 ? 1.f : 0.f; }
        else if (type == 1) { h = hi & 7; r = (hi >> 3) & 63; b = hi >> 9; qrow0 = b * SEQ + r * 64 + wq * 16; qcol = ZNQ + h * 64; kcol = ZNK + h * 64; vcol = ZNV + h * 64; ntiles = 12; rs = min(max(r - 4, 0), 56); }
        else if (type == 2) { const int kvh = hi & 1, qc = (hi >> 1) & 15; b = hi >> 5; h = kvh * 4 + wq; qrow0 = MLAT + b * CTXL + qc * 16; qcol = ZGQ + h * 64; kcol = ZGK + kvh * 64; vcol = ZGV + kvh * 64; ntiles = 4; mrun = sink[h] * LOG2E; lsum = g4 == 0 ? 1.f : 0.f; }
        else { h = hi & 7; const int qc = (hi >> 3) & 3; b = hi >> 5; qrow0 = MLAT + b * CTXL + qc * 64 + wq * 16; qcol = ZNQ + h * 64; kcol = ZNK + h * 64; vcol = ZNV + h * 64; ntiles = 4; }
        if (type == 1) { for (int i = tt; i < 465; i += 256) rpbL[half * 480 + i] = rpb[h * 465 + i] * LOG2E; }
        unsigned vmask = 0u;
        if (type == 1) { const int c_ = 16 * wq + n, cs_ = min(max(c_ - 8, 0), 48);
#pragma unroll
            for (int q_ = 0; q_ < 16; ++q_) { const int kc_ = 16 * (q_ >> 2) + 4 * g4 + (q_ & 3); if (kc_ >= cs_ && kc_ < cs_ + 16) vmask |= 1u << q_; } }
        bf16x8 qf[2];
        {   const bf16_t* qp = z + (size_t)(qrow0 + n) * LDZ + qcol;
#pragma unroll
            for (int ks = 0; ks < 2; ++ks) {
                const u32x4 raw = *(const u32x4*)(qp + 32 * ks + 8 * g4);
                float f[8] = {bflo(raw.x), bfhi(raw.x), bflo(raw.y), bfhi(raw.y), bflo(raw.z), bfhi(raw.z), bflo(raw.w), bfhi(raw.w)};
                if (type == 0) {
                    const u32x4 r2 = *(const u32x4*)(qp + 32 * ks + 8 * (g4 ^ 2));
                    const float f2[8] = {bflo(r2.x), bfhi(r2.x), bflo(r2.y), bfhi(r2.y), bflo(r2.z), bfhi(r2.z), bflo(r2.w), bfhi(r2.w)};
                    const int pos = ks == 0 ? ((q0 + n) >> 6) : ((q0 + n) & 63);
#pragma unroll
                    for (int e = 0; e < 8; ++e) { const f32x2 cs = ropeL[pos * 16 + 8 * (g4 & 1) + e]; f[e] = g4 < 2 ? f[e] * cs.x - f2[e] * cs.y : f2[e] * cs.y + f[e] * cs.x; }
                }
                const float qs = 0.125f * LOG2E;
                u32x4 w; w.x = pk2(f[0] * qs, f[1] * qs); w.y = pk2(f[2] * qs, f[3] * qs); w.z = pk2(f[4] * qs, f[5] * qs); w.w = pk2(f[6] * qs, f[7] * qs);
                qf[ks] = __builtin_bit_cast(bf16x8, w);
            }
        }
        f32x4 oacc[4];
#pragma unroll
        for (int q = 0; q < 4; ++q) oacc[q] = (f32x4){0.f, 0.f, 0.f, 0.f};
        u32x4 kr0, kr1, vr0, vr1, kp0, kp1; int skpos = 0; bool srope = false;
        kp0 = kp1 = (u32x4){0u, 0u, 0u, 0u};
#define ATT_LOAD(t_) do { int krow_; srope = false; skpos = 0; \
            if ((t_) < 4) krow_ = MLAT + b * CTXL + (t_) * 64 + key; \
            else if (type == 0) { skpos = 64 * (t_lo + (t_) - 4) + key; krow_ = b * SEQ + min(max(skpos, 0), SEQ - 1); srope = true; } \
            else krow_ = b * SEQ + (rs + (t_) - 4) * 64 + key; \
            const bf16_t* kp_ = z + (size_t)krow_ * LDZ + kcol + 16 * cp; \
            kr0 = *(const u32x4*)kp_; kr1 = *(const u32x4*)(kp_ + 8); \
            { int va_, vb_; if ((t_) < 4) { va_ = MLAT + b * CTXL + (t_) * 64 + 2 * vkp; vb_ = va_ + 1; } \
              else if (type == 0) { const int p0_ = 64 * (t_lo + (t_) - 4) + 2 * vkp; va_ = b * SEQ + min(max(p0_, 0), SEQ - 1); vb_ = b * SEQ + min(max(p0_ + 1, 0), SEQ - 1); } \
              else { va_ = b * SEQ + (rs + (t_) - 4) * 64 + 2 * vkp; vb_ = va_ + 1; } \
              vr0 = *(const u32x4*)(z + (size_t)va_ * LDZ + vcol + 8 * vch); vr1 = *(const u32x4*)(z + (size_t)vb_ * LDZ + vcol + 8 * vch); } \
            if (srope) { const bf16_t* k2_ = z + (size_t)krow_ * LDZ + kcol + 16 * (cp ^ 1); kp0 = *(const u32x4*)k2_; kp1 = *(const u32x4*)(k2_ + 8); } } while (0)
#define ATT_STORE(buf_) do { LAS unsigned char* Kd_ = lds + ((buf_) * 2 + half) * 18432; LAS unsigned char* Vd_ = Kd_ + 9216; \
            if (srope) { const int kc_ = min(max(skpos, 0), SEQ - 1); const int pos_ = cp < 2 ? (kc_ >> 6) : (kc_ & 63); \
                float a_[16] = {bflo(kr0.x), bfhi(kr0.x), bflo(kr0.y), bfhi(kr0.y), bflo(kr0.z), bfhi(kr0.z), bflo(kr0.w), bfhi(kr0.w), bflo(kr1.x), bfhi(kr1.x), bflo(kr1.y), bfhi(kr1.y), bflo(kr1.z), bfhi(kr1.z), bflo(kr1.w), bfhi(kr1.w)}; \
                const float p_[16] = {bflo(kp0.x), bfhi(kp0.x), bflo(kp0.y), bfhi(kp0.y), bflo(kp0.z), bfhi(kp0.z), bflo(kp0.w), bfhi(kp0.w), bflo(kp1.x), bfhi(kp1.x), bflo(kp1.y), bfhi(kp1.y), bflo(kp1.z), bfhi(kp1.z), bflo(kp1.w), bfhi(kp1.w)}; \
                _Pragma("unroll") for (int e_ = 0; e_ < 16; ++e_) { const f32x2 cs_ = ropeL[pos_ * 16 + e_]; a_[e_] = (cp & 1) == 0 ? a_[e_] * cs_.x - p_[e_] * cs_.y : p_[e_] * cs_.y + a_[e_] * cs_.x; } \
                kr0.x = pk2(a_[0], a_[1]); kr0.y = pk2(a_[2], a_[3]); kr0.z = pk2(a_[4], a_[5]); kr0.w = pk2(a_[6], a_[7]); kr1.x = pk2(a_[8], a_[9]); kr1.y = pk2(a_[10], a_[11]); kr1.z = pk2(a_[12], a_[13]); kr1.w = pk2(a_[14], a_[15]); } \
            *(LAS u32x4*)(Kd_ + key * 144 + cp * 32) = kr0; *(LAS u32x4*)(Kd_ + key * 144 + cp * 32 + 16) = kr1; \
            { const unsigned va4_[4] = {vr0.x, vr0.y, vr0.z, vr0.w}; const unsigned vb4_[4] = {vr1.x, vr1.y, vr1.z, vr1.w}; \
              _Pragma("unroll") for (int e_ = 0; e_ < 4; ++e_) { \
                *(LAS unsigned*)(Vd_ + (8 * vch + 2 * e_) * 144 + vkp * 4) = (va4_[e_] & 0xffffu) | (vb4_[e_] << 16); \
                *(LAS unsigned*)(Vd_ + (8 * vch + 2 * e_ + 1) * 144 + vkp * 4) = (va4_[e_] >> 16) | (vb4_[e_] & 0xffff0000u); } } } while (0)
        ATT_LOAD(0); ATT_STORE(0);
        __syncthreads();
        for (int t = 0; t < ntiles; ++t) {
            if (t + 1 < ntiles) ATT_LOAD(t + 1);
            const LAS unsigned char* Kb = lds + ((t & 1) * 2 + half) * 18432; const LAS unsigned char* Vb = Kb + 9216;
            int need = 0xF;
            if (t >= 4) {
                if (type == 1) need = (wq == 0) ? 0x3 : (wq == 1) ? 0x7 : (wq == 2) ? 0xE : 0xC;
                else { const int kb_ = 64 * (t_lo + t - 4); need = 0;
#pragma unroll
                    for (int kt = 0; kt < 4; ++kt) { const int k0_ = kb_ + 16 * kt; if (k0_ + 15 >= q0 - 128 && k0_ <= q0 + 143 && k0_ >= 0 && k0_ < SEQ) need |= 1 << kt; } }
                need = __builtin_amdgcn_readfirstlane(need);
            }
            f32x4 s[4];
#pragma unroll
            for (int kt = 0; kt < 4; ++kt) {
                if ((need >> kt) & 1) { s[kt] = (f32x4){0.f, 0.f, 0.f, 0.f};
#pragma unroll
                    for (int ks = 0; ks < 2; ++ks) { const bf16x8 a = *(const LAS bf16x8*)(Kb + (16 * kt + n) * 144 + 64 * ks + 16 * g4); s[kt] = __builtin_amdgcn_mfma_f32_16x16x32_bf16(a, qf[ks], s[kt], 0, 0, 0); } }
                else s[kt] = (f32x4){-1e30f, -1e30f, -1e30f, -1e30f};
            }
            if (t >= 4) {
                const int lt = t - 4;
                if (type == 0) { const int kb0 = 64 * (t_lo + lt) + 4 * g4, qpos = q0 + n; const int lo_ = max(qpos - 128, 0), span_ = min(qpos + 128, SEQ - 1) - lo_;
#pragma unroll
                    for (int kt = 0; kt < 4; ++kt) if ((need >> kt) & 1) {
#pragma unroll
                        for (int j = 0; j < 4; ++j) { const int kpos = kb0 + 16 * kt + j; const bool ok = (unsigned)(kpos - lo_) <= (unsigned)span_; s[kt][j] = ok ? s[kt][j] : -1e30f; } } }
                else { const LAS float* rb = rpbL + half * 480 + (rs + lt - r + 7) * 31 + 15 - (16 * wq + n) + 4 * g4;
#pragma unroll
                    for (int kt = 0; kt < 4; ++kt) if ((need >> kt) & 1) {
#pragma unroll
                        for (int j = 0; j < 4; ++j) { const bool ok = (vmask >> (4 * kt + j)) & 1; const float bias = rb[16 * kt + j]; s[kt][j] = ok ? s[kt][j] + bias : -1e30f; } } }
            }
            float mx = s[0][0];
#pragma unroll
            for (int kt = 0; kt < 4; ++kt)
#pragma unroll
                for (int j = 0; j < 4; ++j) mx = fmaxf(mx, s[kt][j]);
            mx = fmaxf(mx, __shfl_xor(mx, 16)); mx = fmaxf(mx, __shfl_xor(mx, 32));
            const float mnew = fmaxf(mrun, mx), alpha = __builtin_amdgcn_exp2f(mrun - mnew); mrun = mnew;
            float psum = 0.f;
#pragma unroll
            for (int kt = 0; kt < 4; ++kt) {
                if ((need >> kt) & 1) {
#pragma unroll
                    for (int j = 0; j < 4; ++j) { const float p = __builtin_amdgcn_exp2f(s[kt][j] - mnew); s[kt][j] = p; psum += p; } }
                else s[kt] = (f32x4){0.f, 0.f, 0.f, 0.f};
            }
            lsum = lsum * alpha + psum;
#pragma unroll
            for (int q = 0; q < 4; ++q) oacc[q] = oacc[q] * alpha;
            bf16x8 pb[2];
#pragma unroll
            for (int ks = 0; ks < 2; ++ks) { u32x4 w; w.x = pk2(s[2 * ks][0], s[2 * ks][1]); w.y = pk2(s[2 * ks][2], s[2 * ks][3]); w.z = pk2(s[2 * ks + 1][0], s[2 * ks + 1][1]); w.w = pk2(s[2 * ks + 1][2], s[2 * ks + 1][3]); pb[ks] = __builtin_bit_cast(bf16x8, w); }
#pragma unroll
            for (int dt = 0; dt < 4; ++dt)
#pragma unroll
                for (int ks = 0; ks < 2; ++ks) if ((need >> (2 * ks)) & 3) { const LAS unsigned char* vp = Vb + (16 * dt + n) * 144 + (32 * ks + 4 * g4) * 2;
                    const u32x2 lo = *(const LAS u32x2*)vp, hi2 = *(const LAS u32x2*)(vp + 32);
                    const u32x4 av = (u32x4){lo.x, lo.y, hi2.x, hi2.y};
                    oacc[dt] = __builtin_amdgcn_mfma_f32_16x16x32_bf16(__builtin_bit_cast(bf16x8, av), pb[ks], oacc[dt], 0, 0, 0); }
            if (t + 1 < ntiles) ATT_STORE((t + 1) & 1);
            __syncthreads();
        }
#undef ATT_LOAD
#undef ATT_STORE
        float ltot = lsum + __shfl_xor(lsum, 16); ltot += __shfl_xor(ltot, 32);
        const float inv = 1.f / ltot;
        bf16_t* op = z + (size_t)(qrow0 + n) * LDZ + qcol + 4 * g4;
        if (dummy) op = dummy + (size_t)(qrow0 + n) * 1024 + ((type & 1) ? 512 : 0) + h * 64 + 4 * g4;
#pragma unroll
        for (int dt = 0; dt < 4; ++dt) { u32x2 w; w.x = pk2(oacc[dt][0] * inv, oacc[dt][1] * inv); w.y = pk2(oacc[dt][2] * inv, oacc[dt][3] * inv); *(u32x2*)(op + 16 * dt) = w; }
    }
}

#define XB_TMO      128
#define XB_XCNT(j)  (256  + 64 * (j))
#define XB_XSUB(j)  (1280 + 64 * (j))
#define XB_XGEN(j)  (2304 + 64 * (j))
#define XB_TOP      3328
#define XB_TOPGEN   3392
#define XCD_BAR_WORDS 3456
#define XB_SPIN_CAP (1u << 18)

__device__ __forceinline__ unsigned xb_ld(unsigned* p)              { return __hip_atomic_load(p, __ATOMIC_RELAXED, __HIP_MEMORY_SCOPE_AGENT); }
__device__ __forceinline__ unsigned xb_add(unsigned* p, unsigned v) { return __hip_atomic_fetch_add(p, v, __ATOMIC_RELAXED, __HIP_MEMORY_SCOPE_AGENT); }
__device__ __forceinline__ unsigned xb_xcc_id() { return (unsigned)__builtin_amdgcn_s_getreg((3 << 11) | 20) & 0xFu; }
#define XB_SPIN(cond, bar) do { unsigned _sp = 0; while (cond) { __builtin_amdgcn_s_sleep(1); \
    if ((++_sp & 255u) == 0u) { if (xb_ld(&(bar)[XB_TMO])) break; if (_sp > XB_SPIN_CAP) { atomicAdd(&(bar)[XB_TMO], 1u); break; } } } } while (0)

struct XcdBarrier {
    unsigned* bar; unsigned x;
    volatile LAS unsigned* st;
};

__device__ __forceinline__ XcdBarrier xcd_barrier_post(unsigned* bar, volatile LAS unsigned* st) {
    XcdBarrier b; b.bar = bar; b.x = xb_xcc_id(); b.st = st;
    if (threadIdx.x == 0) (void)xb_add(&bar[XB_XCNT(b.x)], 1u);
    return b;
}
__device__ __forceinline__ void xcd_barrier_complete(unsigned* bar, unsigned x, unsigned& nloc, unsigned& nx) {
    const unsigned G = gridDim.x * gridDim.y * gridDim.z;
    unsigned sum, cnt, mine, sp = 0u;
    for (;;) {
        sum = 0u; cnt = 0u; mine = 0u;
#pragma unroll
        for (unsigned j = 0; j < 16; ++j) { const unsigned c = xb_ld(&bar[XB_XCNT(j)]); sum += c; cnt += (c > 0u) ? 1u : 0u; mine = (j == x) ? c : mine; }
        if (sum == G) break;
        __builtin_amdgcn_s_sleep(1);
        if ((++sp & 255u) == 0u) { if (xb_ld(&bar[XB_TMO])) break; if (sp > XB_SPIN_CAP) { atomicAdd(&bar[XB_TMO], 1u); break; } }
    }
    nloc = mine > 0u ? mine : 1u; nx = cnt > 0u ? cnt : 1u;
}

__device__ __forceinline__ void xcd_barrier(const XcdBarrier& b) {
    asm volatile("s_waitcnt vmcnt(0)" ::: "memory");
    __syncthreads();
    if (threadIdx.x == 0) {
        unsigned* bar = b.bar;
        __builtin_amdgcn_s_waitcnt(0);
        unsigned nloc = b.st[0], nx = b.st[1];
        if (nloc == 0u) { xcd_barrier_complete(bar, b.x, nloc, nx); b.st[0] = nloc; b.st[1] = nx; }
        const unsigned old = xb_add(&bar[XB_XSUB(b.x)], 1u);
        const unsigned gen = old / nloc;
        if (old + 1u == (gen + 1u) * nloc) {
            __builtin_amdgcn_fence(__ATOMIC_RELEASE, "agent");
            asm volatile("s_waitcnt vmcnt(0)" ::: "memory");
            const unsigned og = xb_add(&bar[XB_TOP], 1u);
            const unsigned tg = og / nx;
            if (og + 1u == (tg + 1u) * nx) xb_add(&bar[XB_TOPGEN], 1u);
            else XB_SPIN(xb_ld(&bar[XB_TOPGEN]) == tg, bar);
            __builtin_amdgcn_fence(__ATOMIC_ACQUIRE, "agent");
            xb_add(&bar[XB_XGEN(b.x)], 1u);
            asm volatile("s_waitcnt vmcnt(0)" ::: "memory");
        } else {
            XB_SPIN(xb_ld(&bar[XB_XGEN(b.x)]) == gen, bar);
            __builtin_amdgcn_fence(__ATOMIC_ACQUIRE, "agent");
            asm volatile("s_waitcnt vmcnt(0)" ::: "memory");
        }
    }
    __syncthreads();
}

#if EXP_SYNC
#define GSYNC() do { xcd_barrier(xbar); xcd_barrier(xbar); } while (0)
#else
#define GSYNC() xcd_barrier(xbar)
#endif
constexpr size_t WS_BAR = 768 * 1024;
struct Args { const float* in[30]; float* out; unsigned char* ws; };
__device__ __forceinline__ const float* karg(int i) { unsigned off = 8u * (unsigned)i; asm volatile("" : "+s"(off));
    const __attribute__((address_space(4))) char* p = (const __attribute__((address_space(4))) char*)__builtin_amdgcn_kernarg_segment_ptr();
    return *(const float* const __attribute__((address_space(4)))*)(p + off); }

#ifdef NO_GEMM
#define GEMM_CALL(EPI, Aptr, lda_, Btptr, M_, N_, K_, Eobj) do { (void)(Eobj); } while (0)
#else
#define GEMM_CALL(EPI, Aptr, lda_, Btptr, M_, N_, K_, Eobj) do { pg8::Gemm g_{(const bf16_t*)(Aptr), (const bf16_t*)(Btptr), (M_), (N_), (K_), (lda_), (K_)}; pg8::StaticOrder S_; S_.init((M_), (N_), G, (int)blockIdx.x); \
        pg8::gemm_phase<EPI, pg8::StaticOrder, true, true>(lds, g_, S_, Eobj); } while (0)
#endif

#define CONV(W, K, N, WT, kind) do { FRESH_IDS; conv_job(lds, (W), (K), (N), (WT), (kind), gw, NGW, lane, wave); } while (0)
#define FFN_CONV(l_, f_) do { const float* wg_ = karg(7 + 3 * (f_)) + (size_t)(l_) * DM * DFF; const float* wu_ = karg(8 + 3 * (f_)) + (size_t)(l_) * DM * DFF; const float* wd_ = karg(9 + 3 * (f_)) + (size_t)(l_) * DFF * DM; \
        CONV(wg_, DM, DFF, slA, 1); CONV(wu_, DM, DFF, slA, 2); CONV(wd_, DFF, DM, slB, 0); } while (0)


#define FRESH_IDS int tid_ = threadIdx.x; asm volatile("" : "+v"(tid_)); const int lane = tid_ & 63; const int wave = __builtin_amdgcn_readfirstlane(tid_ >> 6); const int gw = blockIdx.x * 8 + wave; const int gtid = blockIdx.x * 512 + tid_; (void)lane; (void)wave; (void)gw; (void)gtid;
template <int l>
__device__ __forceinline__ void layer_body(const Args& args, LAS unsigned char* lds, const XcdBarrier& xbar, const int G, const int NGW, const int gthreads) {
    unsigned char* ws = (unsigned char*)karg(31);
    float* mod = (float*)(ws + WS_MOD); float2* rope = (float2*)(ws + WS_ROPE); float2* LAM = (float2*)(ws + WS_LAM); float2* LAMT = (float2*)(ws + WS_LAMT);
    float2* BB = (float2*)(ws + WS_BB); bf16_t* CT = (bf16_t*)(ws + WS_CT); float2* CB = (float2*)(ws + WS_CB); float* xc = (float*)(ws + WS_XC);
    bf16_t* slA = (bf16_t*)(ws + WS_SLA); bf16_t* slB = (bf16_t*)(ws + WS_SLB); bf16_t* slC = (bf16_t*)(ws + WS_SLC);
    bf16_t* H = (bf16_t*)(ws + WS_H); bf16_t* Z = (bf16_t*)(ws + WS_Z); bf16_t* HID = Z; bf16_t* YS = H;
    const float* x = karg(0); const float* ctx = karg(2); float* out = (float*)karg(30);
    const float* norm_g = karg(6);
    {
        const bool ctx_out = (l == 0);
        const float* srcL = l == 0 ? x : out; const float* srcC = l == 0 ? ctx : xc;
        const float* modl = mod + (size_t)l * 9 * 9216;
        const float* gl = norm_g + (size_t)l * 3 * DM;
        if (l == 1) { FFN_CONV(1, 0); }
        { FRESH_IDS; norm_phase(srcL, srcC, gl, modl, 0, 1, H, MALL, gw, NGW, lane); }
        GSYNC();
        { EpiSwiglu E{HID, DFF}; GEMM_CALL(EpiSwiglu, H, DM, slA, MALL, 2 * DFF, DM, E); }
#if EXP_G1
        GSYNC();
        { EpiSwiglu E{HID, DFF}; GEMM_CALL(EpiSwiglu, H, DM, slA, MALL, 2 * DFF, DM, E); }
#endif
        GSYNC();
        { EpiResid E{srcL, srcC, out, xc, modl, 2, 0.5f}; GEMM_CALL(EpiResid, HID, DFF, slB, MALL, DM, DFF, E); }
        GSYNC();
        CONV(karg(13) + (size_t)l * DM * NIN, DM, NIN, slA, 0);
        { FRESH_IDS; zero_rows(slA + (size_t)NIN * DM, (size_t)(LDZ - NIN) * DM * 2 / 16, gtid, gthreads); }
        CONV(karg(22) + (size_t)l * 384 * 384, 384, 384, slC + SC_GLU, 0);
        { FRESH_IDS; zero_rows(slC + SC_GLU + 384 * 384, (size_t)128 * 384 * 2 / 16, gtid, gthreads); }
        CONV(karg(25) + (size_t)l * 384 * DM, 384, DM, slC + SC_PSSM, 0);
        CONV(karg(26) + (size_t)l * 512 * DM, 512, DM, slC + SC_PGQA, 0);
        CONV(karg(27) + (size_t)l * 512 * DM, 512, DM, slC + SC_PNA, 0);
        CONV(karg(28) + (size_t)l * DM * DM, DM, DM, slC + SC_OUT, 0);
        { FRESH_IDS; norm_phase(out, xc, gl + DM, modl, 3, 4, H, MALL, gw, NGW, lane); }
        GSYNC();
        if constexpr (l == 1) { EpiStore E{Z, LDZ}; pg8::Gemm g_{(const bf16_t*)H, (const bf16_t*)slA, MALL, LDZ, DM, DM, DM}; pg8::G3L1Order S_; S_.init(MLAT, LDZ, G, (int)blockIdx.x);
            pg8::gemm_phase<EpiStore, pg8::G3L1Order, true, true>(lds, g_, S_, E); }
        else { EpiStore E{Z, LDZ}; GEMM_CALL(EpiStore, H, DM, slA, MALL, LDZ, DM, E); }
        GSYNC();
#ifndef NO_SSM
        { FRESH_IDS; ssm_chunks<0>(lds, l, Z, (float*)H, LAM, BB, CT, CB, karg(21) + l * 384, gw, NGW, lane, wave); }
#if EXP_SSMA
        { FRESH_IDS; ssm_chunks<0>(lds, l, Z, (float*)H, LAM, BB, CT, CB, karg(21) + l * 384, gw, NGW, lane, wave); }
#endif
        GSYNC();
        { FRESH_IDS; ssm_carry(l, LAMT, CB, gtid); }
        GSYNC();
        { FRESH_IDS; ssm_chunks<1>(lds, l, Z, (float*)H, LAM, BB, CT, CB, karg(21) + l * 384, gw, NGW, lane, wave, !ctx_out); }
        __syncthreads();
#endif
#ifndef NO_ATTN
#if EXP_ATTN
        attn_phase(lds, ctx_out, Z, rope, karg(23) + l * 8, karg(24) + (size_t)l * 8 * 465, G, H);
        __syncthreads();
#endif
        attn_phase(lds, ctx_out, Z, rope, karg(23) + l * 8, karg(24) + (size_t)l * 8 * 465, G);
#endif
        GSYNC();
        const int Mm = ctx_out ? MALL : MLAT;
        { EpiGlu E{Z + ZU, YS}; GEMM_CALL(EpiGlu, Z + ZU, LDZ, slC + SC_GLU, Mm, 512, 384, E); }
        GSYNC();
        { EpiMerge E{Z + ZGATE, Z + ZM, 1}; GEMM_CALL(EpiMerge, YS, 512, slC + SC_PSSM, Mm, DM, 384, E); }
        { EpiMerge E{Z + ZGATE + 1024, Z + ZM, 0}; GEMM_CALL(EpiMerge, Z + ZGQ, LDZ, slC + SC_PGQA, Mm, DM, 512, E); }
        { EpiMerge E{Z + ZGATE + 2048, Z + ZM, 0}; GEMM_CALL(EpiMerge, Z + ZNQ, LDZ, slC + SC_PNA, Mm, DM, 512, E); }
        GSYNC();
        { EpiResid E{out, xc, out, xc, modl, 5, 1.0f}; GEMM_CALL(EpiResid, Z + ZM, LDZ, slC + SC_OUT, Mm, DM, DM, E); }
        GSYNC();
        FFN_CONV(l, 1);
        { FRESH_IDS; norm_phase(out, xc, gl + 2 * DM, modl, 6, 7, H, Mm, gw, NGW, lane); }
        GSYNC();
        { EpiSwiglu E{HID, DFF}; GEMM_CALL(EpiSwiglu, H, DM, slA, Mm, 2 * DFF, DM, E); }
        GSYNC();
        { EpiResid E{out, xc, out, xc, modl, 8, 0.5f}; GEMM_CALL(EpiResid, HID, DFF, slB, Mm, DM, DFF, E); }
        GSYNC();
        }
}

__global__ void __launch_bounds__(512, 2) fwd_megakernel(Args args) {
    extern __shared__ __attribute__((aligned(16))) unsigned char lds_raw[];
    LAS unsigned char* lds = (LAS unsigned char*)lds_raw;
    cg::grid_group grid = cg::this_grid();
    if (threadIdx.x < 16) ((LAS unsigned*)(lds + LDS_BYTES - 64))[threadIdx.x] = 0u;
    __syncthreads();
    XcdBarrier xbar = xcd_barrier_post((unsigned*)((unsigned char*)karg(31) + WS_BAR), (volatile LAS unsigned*)(lds + LDS_BYTES - 64));
    const int G = gridDim.x, NGW = G * 8, gthreads = G * 512;
    unsigned char* ws = (unsigned char*)karg(31);
    float* mod = (float*)(ws + WS_MOD); float2* rope = (float2*)(ws + WS_ROPE); float2* LAM = (float2*)(ws + WS_LAM); float2* LAMT = (float2*)(ws + WS_LAMT);
    float2* BB = (float2*)(ws + WS_BB); bf16_t* CT = (bf16_t*)(ws + WS_CT); float2* CB = (float2*)(ws + WS_CB); float* xc = (float*)(ws + WS_XC);
    bf16_t* slA = (bf16_t*)(ws + WS_SLA); bf16_t* slB = (bf16_t*)(ws + WS_SLB); bf16_t* slC = (bf16_t*)(ws + WS_SLC);
    bf16_t* H = (bf16_t*)(ws + WS_H); bf16_t* Z = (bf16_t*)(ws + WS_Z); bf16_t* HID = Z; bf16_t* YS = H;
    const float* x = karg(0); const float* ctx = karg(2); float* out = (float*)karg(30);
    const float* norm_g = karg(6);
    mod_gemv(lds, karg(1), karg(3), karg(4), karg(5), mod, G);
    { FRESH_IDS; make_tables(karg(14), karg(15), karg(16), karg(17), karg(18), karg(19), karg(20), rope, LAM, LAMT, BB, CT, gtid, gthreads); }
    __syncthreads();
    FFN_CONV(0, 0);
    grid.sync();

    layer_body<0>(args, lds, xbar, G, NGW, gthreads);
    layer_body<1>(args, lds, xbar, G, NGW, gthreads);
    { FRESH_IDS; final_norm(out, karg(29), gw, NGW, lane); }
}

extern "C" void kernel_launch(void* const* d_in, const int* in_sizes, int n_in, void* d_out, int out_size, void* d_ws, size_t ws_size, hipStream_t stream) {
    static int grid = 0;
    if (grid == 0) {
        if (n_in != 30 || out_size != MLAT * DM || ws_size < WS_END) { fprintf(stderr, "kernel_launch: unexpected problem (n_in %d, out %d, ws %zu < %zu)\n", n_in, out_size, ws_size, (size_t)WS_END); grid = -1; return; }
        int dev = 0, cus = 0, per_cu = 0;
        hipGetDevice(&dev); hipDeviceGetAttribute(&cus, hipDeviceAttributeMultiprocessorCount, dev);
        hipFuncSetAttribute((const void*)fwd_megakernel, hipFuncAttributeMaxDynamicSharedMemorySize, LDS_BYTES);
        hipOccupancyMaxActiveBlocksPerMultiprocessor(&per_cu, (const void*)fwd_megakernel, 512, LDS_BYTES);
        if (per_cu < 1) { fprintf(stderr, "kernel_launch: occupancy query says %d blocks/CU\n", per_cu); per_cu = 1; }
        grid = cus * per_cu;
        (void)hipGetLastError();
    }
    if (grid < 0) return;
    Args a{};
    for (int i = 0; i < 30; ++i) a.in[i] = (const float*)d_in[i];
    a.out = (float*)d_out; a.ws = (unsigned char*)d_ws;
    if (hipMemsetAsync((unsigned char*)d_ws + WS_BAR, 0, 16384, stream) != hipSuccess) { fprintf(stderr, "kernel_launch: memset failed\n"); return; }
    void* kargs[] = {&a};
    hipError_t e = hipLaunchCooperativeKernel((const void*)fwd_megakernel, dim3(grid), dim3(512), kargs, LDS_BYTES, stream);
    if (e != hipSuccess) fprintf(stderr, "cooperative launch failed: %s (grid %d)\n", hipGetErrorString(e), grid);
}
```
